# Optimizing an MI355X kernel written in HIP

```python
import math
import jax
import jax.numpy as jnp
from jax import lax
import numpy as np

D_MODEL = 4096
BATCH = 8
SEQ = 2048
DEPTH = 2
DEC_BATCH = 1
DEC_SEQ = 8192
PAST_LEN = 128

GRID_W = 64
NA_HEADS = 8
NA_HEAD_DIM = D_MODEL // 32
NA_WIDTH = NA_HEADS * NA_HEAD_DIM
WIN_R_MAX = 8
WIN_C = 16
Q_BLK_C = 16
KEY_BLK_C = 2 * WIN_C
HY_WIDTH = D_MODEL // 4
HY_ORDER = 2
FILTER_EMB = 33
FILTER_HIDDEN = 64
HY_TARGET = 1e-2
HY_FAST_DECAY = 0.3
HY_SLOW_DECAY = 1.5
HY_MIN_DECAY = math.log(HY_TARGET) / HY_SLOW_DECAY
HY_MAX_DECAY = math.log(HY_TARGET) / HY_FAST_DECAY
RET_HEADS = 8
RET_WIDTH = D_MODEL // 2
RET_HEAD_DIM = RET_WIDTH // RET_HEADS
RET_CHUNK = 128
ROPE_BASE = 10000.0
MIX_WIDTH = NA_WIDTH + HY_WIDTH + RET_WIDTH
IN_COLS = 3 * NA_WIDTH + (HY_ORDER + 1) * HY_WIDTH + 4 * RET_WIDTH
D_FF = ((8 * D_MODEL + 3 * 256 - 1) // (3 * 256)) * 256
ALPHA = (2.0 * DEPTH) ** 0.25
BETA = (8.0 * DEPTH) ** -0.25
LN_EPS = 1e-5
RMS_EPS = 1e-6
NEG_INF = -1e30

kernel_name = 'hybrid_na_hyena_retention_encoder'


def _layernorm(x, g, b):
    xf = x.astype(jnp.float32)
    mu = jnp.mean(xf, -1, keepdims=True)
    var = jnp.mean(jnp.square(xf - mu), -1, keepdims=True)
    return ((xf - mu) * lax.rsqrt(var + LN_EPS) * g + b).astype(x.dtype)


def _rms_norm(x, gain):
    xf = x.astype(jnp.float32)
    y = xf * lax.rsqrt(jnp.mean(xf * xf, -1, keepdims=True) + RMS_EPS)
    return (y * gain).astype(x.dtype)


def _na_tables(rows):
    wr = min(WIN_R_MAX, rows)
    r = np.arange(rows)
    row_start = np.clip(r - wr // 2, 0, rows - wr)
    key_rows = row_start[:, None] + np.arange(wr)[None, :]
    dr_idx = key_rows - r[:, None] + (WIN_R_MAX - 1)
    n_cb = GRID_W // Q_BLK_C
    qcols = np.arange(GRID_W).reshape(n_cb, Q_BLK_C)
    blk_start = np.clip(qcols[:, 0] - WIN_C // 2, 0, GRID_W - KEY_BLK_C)
    key_cols = blk_start[:, None] + np.arange(KEY_BLK_C)[None, :]
    win_start = np.clip(qcols - WIN_C // 2, 0, GRID_W - WIN_C)
    kc = key_cols[:, None, :]
    in_win = (kc >= win_start[:, :, None]) & (kc < win_start[:, :, None] + WIN_C)
    dc_idx = np.clip(kc - qcols[:, :, None] + (WIN_C - 1), 0, 2 * WIN_C - 2)
    return wr, key_rows, dr_idx, key_cols, in_win, dc_idx


def _neighbourhood_attention(q, k, v, rpb):
    bsz, seq_len = q.shape[0], q.shape[1]
    rows = seq_len // GRID_W
    n_cb = GRID_W // Q_BLK_C
    wr, key_rows, dr_idx, key_cols, in_win, dc_idx = _na_tables(rows)
    grid = (bsz, rows, GRID_W, NA_HEADS, NA_HEAD_DIM)
    ri = key_rows[:, None, :, None]
    ci = key_cols[None, :, None, :]
    k_blk = k.reshape(grid)[:, ri, ci]
    v_blk = v.reshape(grid)[:, ri, ci]
    q_blk = q.reshape(bsz, rows, n_cb, Q_BLK_C, NA_HEADS, NA_HEAD_DIM) * (NA_HEAD_DIM ** -0.5)
    s = jnp.einsum('brcqhd,brcwkhd->bhrcqwk', q_blk, k_blk).astype(jnp.float32)
    bias = rpb[:, dr_idx[:, None, None, :, None], dc_idx[None, :, :, None, :]].astype(jnp.float32)
    s = jnp.where(in_win[:, :, None, :], s + bias[None], NEG_INF)
    p = jax.nn.softmax(s.reshape(s.shape[:5] + (wr * KEY_BLK_C,)), axis=-1)
    p = p.reshape(s.shape).astype(v.dtype)
    o = jnp.einsum('bhrcqwk,brcwkhd->brcqhd', p, v_blk)
    return o.reshape(bsz, seq_len, NA_WIDTH)


def _short_conv3(x, w, b):
    xp = jnp.pad(x, ((0, 0), (1, 1), (0, 0)))
    return xp[:, :-2] * w[0] + xp[:, 1:-1] * w[1] + xp[:, 2:] * w[2] + b


def _hyena_filters(seq_len, w1, b1, freq, w2, b2, w3, b3):
    f32 = jnp.float32
    t = jnp.linspace(0.0, 1.0, seq_len, dtype=f32)[:, None]
    bands = (FILTER_EMB - 1) // 2
    fr = jnp.linspace(1e-4, bands - 1, bands, dtype=f32)[None, :]
    wpos = 2.0 * math.pi * jnp.arange(seq_len, dtype=f32)[:, None] / seq_len
    z = jnp.concatenate([t, jnp.cos(fr * wpos), -jnp.sin(fr * wpos)], axis=-1)
    h = jnp.sin(freq[0].astype(f32) * (z @ w1.astype(f32) + b1.astype(f32)))
    h = jnp.sin(freq[1].astype(f32) * (h @ w2.astype(f32) + b2.astype(f32)))
    h = h @ w3.astype(f32) + b3.astype(f32)
    deltas = jnp.abs(jnp.linspace(HY_MIN_DECAY, HY_MAX_DECAY, HY_WIDTH, dtype=f32))
    decay = jnp.exp(-t * deltas[None, :])
    return h.reshape(seq_len, HY_ORDER, 2, HY_WIDTH) * decay[:, None, None, :]


def _bidir_long_conv(u, h_fwd, h_bwd, skip):
    seq_len, ch = h_fwd.shape
    filt = jnp.concatenate([h_fwd, jnp.zeros((1, ch), jnp.float32), h_bwd[1:][::-1]], axis=0)
    uf32 = u.astype(jnp.float32)
    kf = jnp.fft.rfft(filt, n=2 * seq_len, axis=0)
    uf = jnp.fft.rfft(uf32, n=2 * seq_len, axis=1)
    y = jnp.fft.irfft(uf * kf[None], n=2 * seq_len, axis=1)[:, :seq_len]
    return (y + uf32 * skip.astype(jnp.float32)).astype(u.dtype)


def _rotate(x, pos):
    half = RET_HEAD_DIM // 2
    inv_freq = 1.0 / (ROPE_BASE ** jnp.linspace(0.0, 1.0, half, dtype=jnp.float32))
    ang = pos[:, None] * inv_freq[None, :]
    cos = jnp.cos(ang)[None, :, None, :]
    sin = jnp.sin(ang)[None, :, None, :]
    x1, x2 = x[..., :half], x[..., half:]
    return jnp.concatenate([x1 * cos - x2 * sin, x1 * sin + x2 * cos], axis=-1)


def _retention_chunkwise(q, k, v, log_gamma, strict):
    bsz, seq_len, nh, dh = q.shape
    n_chunks = seq_len // RET_CHUNK
    cs = (bsz, n_chunks, RET_CHUNK, nh, dh)
    qc, kc, vc = q.reshape(cs), k.reshape(cs), v.reshape(cs)
    idx = jnp.arange(RET_CHUNK, dtype=jnp.float32)
    diff = idx[:, None] - idx[None, :]
    mask = (diff > 0) if strict else (diff >= 0)
    inner_decay = jnp.where(mask[None], jnp.exp(log_gamma[:, None, None] * jnp.maximum(diff, 0.0)[None]), 0.0)
    s = jnp.einsum('bnihd,bnjhd->bnhij', qc, kc) * inner_decay
    inner = jnp.einsum('bnhij,bnjhv->bnihv', s, vc)
    zeta = jnp.exp(log_gamma[:, None] * (RET_CHUNK - 1 - idx)[None, :])
    kv = jnp.einsum('bnjhd,bnjhv,hj->bnhdv', kc, vc, zeta)
    chunk_decay = jnp.exp(log_gamma * RET_CHUNK)[None, :, None, None]

    def step(state, kv_i):
        return state * chunk_decay + kv_i, state

    init = jnp.zeros((bsz, nh, dh, dh), jnp.float32)
    _, prev = lax.scan(step, init, jnp.moveaxis(kv, 1, 0))
    prev = jnp.moveaxis(prev, 0, 1)
    xi = jnp.exp(log_gamma[:, None] * (idx + 1.0)[None, :])
    cross = jnp.einsum('bnihd,bnhdv,hi->bnihv', qc, prev, xi)
    return (inner + cross).reshape(bsz, seq_len, nh, dh)


def _token_mixers(x, w_in, na_rpb, hy_conv_w, hy_conv_b, hy_f_w1, hy_f_b1, hy_f_freq, hy_f_w2, hy_f_b2,
                  hy_f_w3, hy_f_b3, hy_skip, ret_decay_exp, grp_gain_a, grp_gain_b, w_out):
    bsz, seq_len, _ = x.shape
    f32 = jnp.float32
    proj = jnp.einsum('bld,dc->blc', x, w_in)
    s1 = 3 * NA_WIDTH
    s2 = s1 + (HY_ORDER + 1) * HY_WIDTH
    s3 = s2 + RET_WIDTH
    s4 = s3 + RET_WIDTH
    s5 = s4 + RET_WIDTH
    a_qkv, hy_in, r_q, r_k, r_v, r_g = jnp.split(proj, [s1, s2, s3, s4, s5], axis=-1)

    a_q, a_k, a_v = jnp.split(a_qkv, 3, axis=-1)
    a_out = _rms_norm(_neighbourhood_attention(a_q, a_k, a_v, na_rpb), grp_gain_a)

    hy = _short_conv3(hy_in, hy_conv_w, hy_conv_b)
    hv, hx1, hx2 = jnp.split(hy, 3, axis=-1)
    filt = _hyena_filters(seq_len, hy_f_w1, hy_f_b1, hy_f_freq, hy_f_w2, hy_f_b2, hy_f_w3, hy_f_b3)
    gates = (hx1, hx2)
    z = hv
    for o in range(HY_ORDER):
        z = gates[o] * _bidir_long_conv(z, filt[:, o, 0], filt[:, o, 1], hy_skip[o])
    b_out = _rms_norm(z, grp_gain_b)

    pos = jnp.arange(seq_len, dtype=f32)
    shp = (bsz, seq_len, RET_HEADS, RET_HEAD_DIM)
    rq = _rotate(r_q.reshape(shp).astype(f32), pos)
    rk = _rotate(r_k.reshape(shp).astype(f32), pos) * (RET_HEAD_DIM ** -0.5)
    rv = r_v.reshape(shp).astype(f32)
    log_gamma = jnp.log1p(-jnp.exp2(-ret_decay_exp.astype(f32)))
    fwd = _retention_chunkwise(rq, rk, rv, log_gamma[0], False)
    bwd = jnp.flip(_retention_chunkwise(jnp.flip(rq, 1), jnp.flip(rk, 1), jnp.flip(rv, 1), log_gamma[1], True), 1)
    ret = fwd + bwd
    ret = ret * lax.rsqrt(jnp.mean(ret * ret, -1, keepdims=True) + RMS_EPS)
    c_out = (ret.reshape(bsz, seq_len, RET_WIDTH) * jax.nn.silu(r_g.astype(f32))).astype(x.dtype)

    mixed = jnp.concatenate([a_out, b_out, c_out], axis=-1)
    return jnp.einsum('blm,md->bld', mixed, w_out)


def _swiglu(x, w_ffn_in, w_ffn_out):
    gu = jnp.einsum('bld,df->blf', x, w_ffn_in)
    g, u = jnp.split(gu, 2, axis=-1)
    return jnp.einsum('blf,fd->bld', jax.nn.silu(g) * u, w_ffn_out)


def _trunk(x, ln_in_g, ln_in_b, w_in, na_rpb, hy_conv_w, hy_conv_b, hy_f_w1, hy_f_b1, hy_f_freq, hy_f_w2,
           hy_f_b2, hy_f_w3, hy_f_b3, hy_skip, ret_decay_exp, grp_gain_a, grp_gain_b, w_out, ln1_g, ln1_b,
           w_ffn_in, w_ffn_out, ln2_g, ln2_b):
    x = _layernorm(x, ln_in_g, ln_in_b)
    for l in range(DEPTH):
        h = _token_mixers(x, w_in[l], na_rpb[l], hy_conv_w[l], hy_conv_b[l], hy_f_w1[l], hy_f_b1[l],
                          hy_f_freq[l], hy_f_w2[l], hy_f_b2[l], hy_f_w3[l], hy_f_b3[l], hy_skip[l],
                          ret_decay_exp[l], grp_gain_a[l], grp_gain_b[l], w_out[l])
        x = _layernorm(ALPHA * x + h, ln1_g[l], ln1_b[l])
        x = _layernorm(ALPHA * x + _swiglu(x, w_ffn_in[l], w_ffn_out[l]), ln2_g[l], ln2_b[l])
    return x


def setup_inputs(seed: int = 0) -> dict:
    key = jax.random.key(seed)
    ks = jax.random.split(key, 26)
    f32 = jnp.float32

    def nrm(k, shape, scale):
        return jax.random.normal(k, shape, f32) * scale

    col_scale = np.ones((IN_COLS,), np.float32)
    col_scale[2 * NA_WIDTH:3 * NA_WIDTH] = BETA
    hy0 = 3 * NA_WIDTH
    col_scale[hy0:hy0 + HY_WIDTH] = BETA
    rv0 = hy0 + (HY_ORDER + 1) * HY_WIDTH + 2 * RET_WIDTH
    col_scale[rv0:rv0 + RET_WIDTH] = BETA
    hy_cols = (HY_ORDER + 1) * HY_WIDTH
    return {
        'x_prompt': nrm(ks[0], (BATCH, SEQ, D_MODEL), 1.0),
        'x_sample': nrm(ks[1], (DEC_BATCH, DEC_SEQ, D_MODEL), 1.0),
        'ln_in_g': 1.0 + nrm(ks[2], (D_MODEL,), 0.02),
        'ln_in_b': nrm(ks[3], (D_MODEL,), 0.02),
        'w_in': nrm(ks[4], (DEPTH, D_MODEL, IN_COLS), D_MODEL ** -0.5) * jnp.asarray(col_scale),
        'na_rpb': nrm(ks[5], (DEPTH, NA_HEADS, 2 * WIN_R_MAX - 1, 2 * WIN_C - 1), 0.02),
        'hy_conv_w': nrm(ks[6], (DEPTH, 3, hy_cols), 3 ** -0.5),
        'hy_conv_b': nrm(ks[7], (DEPTH, hy_cols), 0.02),
        'hy_f_w1': nrm(ks[8], (DEPTH, FILTER_EMB, FILTER_HIDDEN), FILTER_EMB ** -0.5),
        'hy_f_b1': nrm(ks[9], (DEPTH, FILTER_HIDDEN), 0.02),
        'hy_f_freq': 1.0 + nrm(ks[10], (DEPTH, 2, FILTER_HIDDEN), 0.02),
        'hy_f_w2': nrm(ks[11], (DEPTH, FILTER_HIDDEN, FILTER_HIDDEN), FILTER_HIDDEN ** -0.5),
        'hy_f_b2': nrm(ks[12], (DEPTH, FILTER_HIDDEN), 0.02),
        'hy_f_w3': nrm(ks[13], (DEPTH, FILTER_HIDDEN, HY_ORDER * 2 * HY_WIDTH), FILTER_HIDDEN ** -0.5),
        'hy_f_b3': nrm(ks[14], (DEPTH, HY_ORDER * 2 * HY_WIDTH), 0.02),
        'hy_skip': nrm(ks[15], (DEPTH, HY_ORDER, HY_WIDTH), 1.0),
        'ret_decay_exp': 5.0 + jnp.arange(RET_HEADS, dtype=f32) + nrm(ks[16], (DEPTH, 2, RET_HEADS), 0.1),
        'grp_gain_a': 1.0 + nrm(ks[17], (DEPTH, NA_WIDTH), 0.02),
        'grp_gain_b': 1.0 + nrm(ks[18], (DEPTH, HY_WIDTH), 0.02),
        'w_out': nrm(ks[19], (DEPTH, MIX_WIDTH, D_MODEL), MIX_WIDTH ** -0.5 * BETA),
        'ln1_g': 1.0 + nrm(ks[20], (DEPTH, D_MODEL), 0.02),
        'ln1_b': nrm(ks[21], (DEPTH, D_MODEL), 0.02),
        'w_ffn_in': nrm(ks[22], (DEPTH, D_MODEL, 2 * D_FF), D_MODEL ** -0.5 * BETA),
        'w_ffn_out': nrm(ks[23], (DEPTH, D_FF, D_MODEL), D_FF ** -0.5 * BETA),
        'ln2_g': 1.0 + nrm(ks[24], (DEPTH, D_MODEL), 0.02),
        'ln2_b': nrm(ks[25], (DEPTH, D_MODEL), 0.02),
    }


def reference(x_prompt, x_sample, ln_in_g, ln_in_b, w_in, na_rpb, hy_conv_w, hy_conv_b, hy_f_w1, hy_f_b1,
              hy_f_freq, hy_f_w2, hy_f_b2, hy_f_w3, hy_f_b3, hy_skip, ret_decay_exp, grp_gain_a, grp_gain_b,
              w_out, ln1_g, ln1_b, w_ffn_in, w_ffn_out, ln2_g, ln2_b):
    params = (ln_in_g, ln_in_b, w_in, na_rpb, hy_conv_w, hy_conv_b, hy_f_w1, hy_f_b1, hy_f_freq, hy_f_w2,
              hy_f_b2, hy_f_w3, hy_f_b3, hy_skip, ret_decay_exp, grp_gain_a, grp_gain_b, w_out, ln1_g, ln1_b,
              w_ffn_in, w_ffn_out, ln2_g, ln2_b)
    y_prompt = _trunk(x_prompt, *params)
    y_sample = _trunk(x_sample, *params)
    return (y_prompt, y_sample)
```

```cpp
#include <hip/hip_runtime.h>
#include <cstdio>
#include <cstdint>
namespace pg8 {
#define PG8_LAS __attribute__((address_space(3)))
typedef unsigned short bf16_t;
typedef short bf16x8 __attribute__((ext_vector_type(8)));
typedef float f32x4 __attribute__((ext_vector_type(4)));
typedef unsigned u32x4 __attribute__((ext_vector_type(4)));
constexpr int BM = 256, BK = 64, HALF = 128, HTB = HALF * BK * 2  , STAGE_BYTES = 8 * HTB, NXCD = 8, WGM = 8;

__host__ __device__ __forceinline__ int lds_byte(int r, int c) { const int st = (r >> 4) * 2 + (c >> 5), rr = r & 15, cc = c & 31, ob = rr * 64 + cc * 2; return st * 1024 + (ob ^ (((ob >> 9) & 1) << 5)); }
__host__ __device__ __forceinline__ void stage_rc(int b, int& R, int& C) { const int st = b / 1024, sb = b % 1024, swz = sb ^ (((sb >> 9) & 1) << 5); R = (st >> 1) * 16 + swz / 64; C = (st & 1) * 32 + (swz % 64) / 2; }
__host__ __device__ __forceinline__ int perm32(int rho) { const int n = rho >> 4, i = rho & 15; return 8 * (i >> 2) + 4 * n + (i & 3); }

struct Unit { int pm, pn; };
struct Gemm { const bf16_t* A; const bf16_t* Bt; int M, N, K; };

struct StaticOrder {
    int nM, nN, nwg, G, c;
    __host__ __device__ void init(int M, int N, int G_, int c_) { nM = M / BM; nN = N / BM; nwg = nM * nN; G = G_; c = c_; }
    __host__ __device__ bool next(int i, Unit& u) const {
        const long L = (long)i * G + c; if (L >= nwg) return false;
        int wgid = (int)L; { const int q = nwg / NXCD, r = nwg % NXCD, xcd = wgid % NXCD, off = wgid / NXCD; wgid = (xcd < r ? xcd * (q + 1) : r * (q + 1) + (xcd - r) * q) + off; }
        const int nig = WGM * nN, gid = wgid / nig, fm = gid * WGM, gsz = (nM - fm) < WGM ? (nM - fm) : WGM;
        u.pm = fm + ((wgid % nig) % gsz); u.pn = (wgid % nig) / gsz; return true;
    }
    __device__ __forceinline__ void a_ready(const Unit&) const {}
    __device__ __forceinline__ void done(const Unit&) const {}
};

__device__ __forceinline__ unsigned cvt_pk_bf16(float lo, float hi) { unsigned r; asm volatile("v_cvt_pk_bf16_f32 %0, %1, %2" : "=v"(r) : "v"(lo), "v"(hi)); return r; }

typedef int i32x4 __attribute__((ext_vector_type(4)));
template <bool I8> struct AccSel { typedef f32x4 type; };
template <> struct AccSel<true> { typedef i32x4 type; };
typedef _Float16 f16x8 __attribute__((ext_vector_type(8)));
template <class Epi, class Sched, bool ALIGN_EPI = false, bool SP2 = false, bool I8 = false, bool F16 = false>
__device__ __forceinline__ void gemm_phase(PG8_LAS unsigned char* lds, const Gemm g, const Sched& S, const Epi& E) {
    int tid_l = threadIdx.x; asm volatile("" : "+v"(tid_l));
    const int tid = tid_l, wid = __builtin_amdgcn_readfirstlane(tid >> 6), lane = tid & 63, wr = wid >> 2, wc = wid & 3, fr = lane & 15, fq = lane >> 4;
    const int K = I8 ? g.K / 2 : g.K, nt = K / BK;
    unsigned voffA[2], voffB[2];
#pragma unroll
    for (int i = 0; i < 2; ++i) { int R, C; stage_rc(tid * 16 + i * 8192, R, C); const int Rb = Epi::PERM ? ((R & ~31) + perm32(R & 31)) : R;
        voffA[i] = (unsigned)(R * K + C) * 2u; voffB[i] = (unsigned)(Rb * K + C) * 2u; }
    const size_t kstep = (size_t)(BK * 2);
    const size_t hstep = (size_t)HALF * K * 2;
    const size_t tstep = 2 * hstep;
    const unsigned ldsw = (unsigned)wid * 1024u;
    const int aoff = lds_byte(wr * 64 + fr, fq * 8), boff = lds_byte(wc * 32 + fr, fq * 8);
#define PG8_SA(b, h) (((b) * 2 + (h)) * HTB)
#define PG8_SB(b, h) ((4 + (b) * 2 + (h)) * HTB)
#define PG8_STAGE(bufoff, gbase, voff) do { _Pragma("unroll") for (int _i = 0; _i < 2; ++_i) \
        __builtin_amdgcn_global_load_lds((const unsigned*)((const char*)(gbase) + (voff)[_i]), (PG8_LAS unsigned*)(lds + (bufoff) + ldsw + _i * 8192), 16, 0, 0); } while (0)
#define PG8_LDA(dst, b, h) do { _Pragma("unroll") for (int m = 0; m < 4; ++m) _Pragma("unroll") for (int k = 0; k < 2; ++k) dst[m][k] = *(const PG8_LAS bf16x8*)(lds + PG8_SA(b, h) + aoff + m * 2048 + k * 1024); } while (0)
#define PG8_LDB(dst, b, h) do { _Pragma("unroll") for (int n = 0; n < 2; ++n) _Pragma("unroll") for (int k = 0; k < 2; ++k) dst[n][k] = *(const PG8_LAS bf16x8*)(lds + PG8_SB(b, h) + boff + n * 2048 + k * 1024); } while (0)
#define PG8_MMA(ai, bj, At, Bt) do { __builtin_amdgcn_s_setprio(1); _Pragma("unroll") for (int m = 0; m < 4; ++m) _Pragma("unroll") for (int n = 0; n < 2; ++n) _Pragma("unroll") for (int k = 0; k < 2; ++k) \
        { if constexpr (I8) acc[ai][bj][m][n] = __builtin_amdgcn_mfma_i32_16x16x64_i8(__builtin_bit_cast(i32x4, Bt[n][k]), __builtin_bit_cast(i32x4, At[m][k]), acc[ai][bj][m][n], 0, 0, 0); \
          else if constexpr (F16) acc[ai][bj][m][n] = __builtin_amdgcn_mfma_f32_16x16x32_f16(__builtin_bit_cast(f16x8, Bt[n][k]), __builtin_bit_cast(f16x8, At[m][k]), acc[ai][bj][m][n], 0, 0, 0); \
          else acc[ai][bj][m][n] = __builtin_amdgcn_mfma_f32_16x16x32_bf16(Bt[n][k], At[m][k], acc[ai][bj][m][n], 0, 0, 0); } __builtin_amdgcn_s_setprio(0); } while (0)
#define PG8_WAIT_V(n) asm volatile("s_waitcnt vmcnt(" #n ")" ::: "memory")
#define PG8_WAIT_L(n) asm volatile("s_waitcnt lgkmcnt(" #n ")" ::: "memory")
#define PG8_BAR __builtin_amdgcn_s_barrier()
#define PG8_SCHED __builtin_amdgcn_sched_barrier(0)
    Unit cur, nxt; int ui = 0;
    if (!S.next(0, cur)) return;
    typedef typename AccSel<I8>::type accv_t;
    accv_t acc[2][2][4][2];
#pragma unroll
    for (int a = 0; a < 2; ++a)
#pragma unroll
        for (int b = 0; b < 2; ++b)
#pragma unroll
            for (int m = 0; m < 4; ++m)
#pragma unroll
                for (int n = 0; n < 2; ++n) acc[a][b][m][n] = (accv_t){0, 0, 0, 0};
    bf16x8 At[4][2], B0[2][2], B1[2][2];
    const char* cA = (const char*)g.A + (size_t)cur.pm * tstep; const char* cB = (const char*)g.Bt + (size_t)cur.pn * tstep;
    S.a_ready(cur);
    if constexpr (SP2) {
        PG8_STAGE(PG8_SB(0, 0), cB, voffB); PG8_STAGE(PG8_SB(0, 1), cB + hstep, voffB); PG8_STAGE(PG8_SA(0, 0), cA, voffA); PG8_STAGE(PG8_SA(0, 1), cA + hstep, voffA);
        if (wr == 1) PG8_BAR;
        PG8_WAIT_V(2); PG8_BAR;
        PG8_STAGE(PG8_SB(1, 0), cB + kstep, voffB); PG8_STAGE(PG8_SA(1, 0), cA + kstep, voffA); PG8_STAGE(PG8_SB(1, 1), cB + hstep + kstep, voffB);
        PG8_WAIT_V(6); PG8_BAR;
    } else {
        PG8_STAGE(PG8_SB(0, 0), cB, voffB); PG8_STAGE(PG8_SA(0, 0), cA, voffA); PG8_STAGE(PG8_SB(0, 1), cB + hstep, voffB); PG8_STAGE(PG8_SA(0, 1), cA + hstep, voffA);
        if (wr == 1) PG8_BAR;
        PG8_WAIT_V(4); PG8_BAR;
        PG8_STAGE(PG8_SB(1, 0), cB + kstep, voffB); PG8_STAGE(PG8_SA(1, 0), cA + kstep, voffA); PG8_STAGE(PG8_SB(1, 1), cB + hstep + kstep, voffB);
        PG8_WAIT_V(6); PG8_BAR;
    }
    for (;;) {
        const bool has_next = S.next(ui + 1, nxt);
        const char* nA = has_next ? (const char*)g.A + (size_t)nxt.pm * tstep : cA; const char* nB = has_next ? (const char*)g.Bt + (size_t)nxt.pn * tstep : cB;
        for (int t = 0; t < nt; t += 2) {
            const bool last = (t == nt - 2);
            const char* a1 = cA + (size_t)(t + 1) * kstep;
            const char* a2 = last ? nA : cA + (size_t)(t + 2) * kstep; const char* b2 = last ? nB : cB + (size_t)(t + 2) * kstep;
            const char* a3 = a2 + kstep; const char* b3 = b2 + kstep;
            if (last && has_next) S.a_ready(nxt);
            if constexpr (SP2) {
            PG8_LDB(B0, 0, 0); PG8_LDB(B1, 0, 1); PG8_SCHED; PG8_LDA(At, 0, 0); PG8_STAGE(PG8_SA(1, 1), a1 + hstep, voffA);
            PG8_WAIT_V(8); PG8_WAIT_L(0); PG8_BAR; PG8_MMA(0, 0, At, B0); PG8_MMA(0, 1, At, B1); PG8_BAR; PG8_SCHED;
            PG8_LDA(At, 0, 1); PG8_STAGE(PG8_SB(0, 0), b2, voffB); PG8_STAGE(PG8_SB(0, 1), b2 + hstep, voffB); PG8_STAGE(PG8_SA(0, 0), a2, voffA);
            PG8_WAIT_V(8); PG8_WAIT_L(0); PG8_BAR; PG8_MMA(1, 0, At, B0); PG8_MMA(1, 1, At, B1); PG8_BAR; PG8_SCHED;
            PG8_LDB(B0, 1, 0); PG8_LDB(B1, 1, 1); PG8_SCHED; PG8_LDA(At, 1, 0); PG8_STAGE(PG8_SA(0, 1), a2 + hstep, voffA);
            PG8_WAIT_V(8); PG8_WAIT_L(0); PG8_BAR; PG8_MMA(0, 0, At, B0); PG8_MMA(0, 1, At, B1); PG8_BAR; PG8_SCHED;
            PG8_LDA(At, 1, 1); PG8_STAGE(PG8_SB(1, 0), b3, voffB); PG8_STAGE(PG8_SB(1, 1), b3 + hstep, voffB); PG8_STAGE(PG8_SA(1, 0), a3, voffA);
            PG8_WAIT_V(8); PG8_WAIT_L(0); PG8_BAR; PG8_MMA(1, 0, At, B0); PG8_MMA(1, 1, At, B1); PG8_BAR; PG8_SCHED;
            } else {
            PG8_LDB(B0, 0, 0); PG8_SCHED; PG8_LDA(At, 0, 0); PG8_STAGE(PG8_SA(1, 1), a1 + hstep, voffA);
            PG8_WAIT_L(8); PG8_BAR; PG8_WAIT_L(0); PG8_MMA(0, 0, At, B0); PG8_BAR; PG8_SCHED;
            PG8_LDB(B1, 0, 1); PG8_STAGE(PG8_SB(0, 0), b2, voffB);
            PG8_BAR; PG8_WAIT_L(0); PG8_MMA(0, 1, At, B1); PG8_BAR;
            PG8_LDA(At, 0, 1); PG8_STAGE(PG8_SA(0, 0), a2, voffA);
            PG8_BAR; PG8_WAIT_L(0); PG8_MMA(1, 0, At, B0); PG8_BAR; PG8_SCHED;
            PG8_STAGE(PG8_SB(0, 1), b2 + hstep, voffB);
            PG8_WAIT_V(6); PG8_BAR; PG8_MMA(1, 1, At, B1); PG8_BAR;
            PG8_LDB(B0, 1, 0); PG8_SCHED; PG8_LDA(At, 1, 0); PG8_STAGE(PG8_SA(0, 1), a2 + hstep, voffA);
            PG8_WAIT_L(8); PG8_BAR; PG8_WAIT_L(0); PG8_MMA(0, 0, At, B0); PG8_BAR; PG8_SCHED;
            PG8_LDB(B1, 1, 1); PG8_STAGE(PG8_SB(1, 0), b3, voffB);
            PG8_BAR; PG8_WAIT_L(0); PG8_MMA(0, 1, At, B1); PG8_BAR;
            PG8_LDA(At, 1, 1); PG8_STAGE(PG8_SA(1, 0), a3, voffA);
            PG8_BAR; PG8_WAIT_L(0); PG8_MMA(1, 0, At, B0); PG8_BAR; PG8_SCHED;
            PG8_STAGE(PG8_SB(1, 1), b3 + hstep, voffB);
            PG8_WAIT_V(6); PG8_BAR; PG8_MMA(1, 1, At, B1); PG8_BAR;
            }
        }
        if constexpr (ALIGN_EPI) { if (wr == 0) PG8_BAR; }
        if constexpr (!Epi::AFTER_DRAIN) { E(acc, cur, wr, wc, fr, fq); S.done(cur); }
        if (!has_next) break;
#pragma unroll
        for (int a = 0; a < 2; ++a)
#pragma unroll
            for (int b = 0; b < 2; ++b)
#pragma unroll
                for (int m = 0; m < 4; ++m)
#pragma unroll
                    for (int n = 0; n < 2; ++n) acc[a][b][m][n] = (accv_t){0, 0, 0, 0};
        cur = nxt; cA = nA; cB = nB; ++ui;
        if constexpr (ALIGN_EPI) { if (wr == 1) PG8_BAR; }
    }
    PG8_WAIT_V(0);
    if constexpr (!ALIGN_EPI) { if (wr == 0) PG8_BAR; }
    PG8_BAR;
    if constexpr (Epi::AFTER_DRAIN) { E.fused(acc, cur, wr, wc, fr, fq, lds, wid, lane); S.done(cur); }
#undef PG8_SA
#undef PG8_SB
#undef PG8_STAGE
#undef PG8_LDA
#undef PG8_LDB
#undef PG8_MMA
#undef PG8_WAIT_V
#undef PG8_WAIT_L
#undef PG8_BAR
#undef PG8_SCHED
}

struct EpiProj {
    static constexpr bool PERM = true, AFTER_DRAIN = false;
    bf16_t* O; const float* rope;
    __device__ __forceinline__ void operator()(const f32x4 (&acc)[2][2][4][2], const Unit& u, int wr, int wc, int fr, int fq) const {
        const int pn = u.pn < 8 ? u.pn : u.pn + 8;
        const int row0 = u.pm * BM + wr * 64 + fr, col0 = pn * BM + wc * 32 + 8 * fq;
        const bool rot = (pn >= 24) && (pn < 40);
        const float ksc = (pn >= 32 && pn < 40) ? 0.0625f : 1.0f;
#pragma unroll
        for (int ai = 0; ai < 2; ++ai)
#pragma unroll
            for (int m = 0; m < 4; ++m) {
                const int row = row0 + ai * HALF + m * 16;
                bf16_t* rowp = O + (size_t)row * 14336 + col0;
                f32x4 a0 = acc[ai][0][m][0], a1 = acc[ai][0][m][1], b0 = acc[ai][1][m][0], b1 = acc[ai][1][m][1];
                if (rot) {
                    const int pos = row < 16384 ? (row & 2047) : (row - 16384);
                    const f32x4* rp = (const f32x4*)(rope + ((size_t)pos * 128 + wc * 32 + 8 * fq) * 2);
                    const f32x4 r0 = rp[0], r1 = rp[1], r2 = rp[2], r3 = rp[3];
                    const f32x4 c0 = {r0.x, r0.z, r1.x, r1.z}, s0 = {r0.y, r0.w, r1.y, r1.w}, c1 = {r2.x, r2.z, r3.x, r3.z}, s1 = {r2.y, r2.w, r3.y, r3.w};
                    const f32x4 na0 = a0 * c0 - b0 * s0, nb0 = a0 * s0 + b0 * c0, na1 = a1 * c1 - b1 * s1, nb1 = a1 * s1 + b1 * c1;
                    a0 = na0 * ksc; b0 = nb0 * ksc; a1 = na1 * ksc; b1 = nb1 * ksc;
                }
                u32x4 w0, w1;
                w0.x = cvt_pk_bf16(a0[0], a0[1]); w0.y = cvt_pk_bf16(a0[2], a0[3]); w0.z = cvt_pk_bf16(a1[0], a1[1]); w0.w = cvt_pk_bf16(a1[2], a1[3]);
                w1.x = cvt_pk_bf16(b0[0], b0[1]); w1.y = cvt_pk_bf16(b0[2], b0[3]); w1.z = cvt_pk_bf16(b1[0], b1[1]); w1.w = cvt_pk_bf16(b1[2], b1[3]);
                *(u32x4*)(rowp) = w0; *(u32x4*)(rowp + HALF) = w1;
            }
    }
};
__device__ __forceinline__ f32x4 bf4lo(const u32x4 w) { f32x4 r; r.x = __builtin_bit_cast(float, w.x << 16); r.y = __builtin_bit_cast(float, w.x & 0xffff0000u); r.z = __builtin_bit_cast(float, w.y << 16); r.w = __builtin_bit_cast(float, w.y & 0xffff0000u); return r; }
__device__ __forceinline__ f32x4 bf4hi(const u32x4 w) { f32x4 r; r.x = __builtin_bit_cast(float, w.z << 16); r.y = __builtin_bit_cast(float, w.z & 0xffff0000u); r.z = __builtin_bit_cast(float, w.w << 16); r.w = __builtin_bit_cast(float, w.w & 0xffff0000u); return r; }
__device__ __forceinline__ u32x4 pk8(const f32x4 a, const f32x4 b) { u32x4 w; w.x = cvt_pk_bf16(a[0], a[1]); w.y = cvt_pk_bf16(a[2], a[3]); w.z = cvt_pk_bf16(b[0], b[1]); w.w = cvt_pk_bf16(b[2], b[3]); return w; }
typedef float f2v_t __attribute__((ext_vector_type(2))); typedef _Float16 h2v_t __attribute__((ext_vector_type(2)));
__device__ __forceinline__ unsigned pkh(float a, float b) { const f2v_t f = {a, b}; const h2v_t h = __builtin_convertvector(f, h2v_t); return __builtin_bit_cast(unsigned, h); }
__device__ __forceinline__ float hlo(unsigned w) { return (float)__builtin_bit_cast(_Float16, (unsigned short)(w & 0xffffu)); }
__device__ __forceinline__ float hhi(unsigned w) { return (float)__builtin_bit_cast(_Float16, (unsigned short)(w >> 16)); }
__device__ __forceinline__ u32x4 pk8h(const f32x4 a, const f32x4 b) { u32x4 w; w.x = pkh(a[0], a[1]); w.y = pkh(a[2], a[3]); w.z = pkh(b[0], b[1]); w.w = pkh(b[2], b[3]); return w; }
__device__ __forceinline__ f32x4 h4lo(const u32x4 w) { return (f32x4){hlo(w.x), hhi(w.x), hlo(w.y), hhi(w.y)}; }
__device__ __forceinline__ f32x4 h4hi(const u32x4 w) { return (f32x4){hlo(w.z), hhi(w.z), hlo(w.w), hhi(w.w)}; }
struct EpiRes {
    static constexpr bool PERM = true, AFTER_DRAIN = false;
    bf16_t* X; const bf16_t* Y; float alpha;
    __device__ __forceinline__ void operator()(const f32x4 (&acc)[2][2][4][2], const Unit& u, int wr, int wc, int fr, int fq) const {
        const int row0 = u.pm * BM + wr * 64 + fr, col0 = u.pn * BM + wc * 32 + 8 * fq;
#pragma unroll
        for (int ai = 0; ai < 2; ++ai) {
            u32x4 y[4][2];
#pragma unroll
            for (int m = 0; m < 4; ++m) { const bf16_t* yp = Y + (size_t)(row0 + ai * HALF + m * 16) * 4096 + col0; y[m][0] = *(const u32x4*)yp; y[m][1] = *(const u32x4*)(yp + HALF); }
#pragma unroll
            for (int m = 0; m < 4; ++m) { bf16_t* rowp = X + (size_t)(row0 + ai * HALF + m * 16) * 4096 + col0;
#pragma unroll
                for (int bj = 0; bj < 2; ++bj) *(u32x4*)(rowp + bj * HALF) = pk8h(h4lo(y[m][bj]) * alpha + acc[ai][bj][m][0], h4hi(y[m][bj]) * alpha + acc[ai][bj][m][1]); }
            asm volatile("" ::: "memory");
        }
    }
};
struct EpiSwiglu {
    static constexpr bool PERM = true, AFTER_DRAIN = false;
    bf16_t* H;
    __device__ __forceinline__ void operator()(const f32x4 (&acc)[2][2][4][2], const Unit& u, int wr, int wc, int fr, int fq) const {
        const int row0 = u.pm * BM + wr * 64 + fr, col0 = u.pn * HALF + wc * 32 + 8 * fq;
#pragma unroll
        for (int ai = 0; ai < 2; ++ai)
#pragma unroll
            for (int m = 0; m < 4; ++m) {
                bf16_t* rowp = H + (size_t)(row0 + ai * HALF + m * 16) * 11008 + col0;
                f32x4 h0, h1;
#pragma unroll
                for (int j = 0; j < 4; ++j) {
                    const float g0 = acc[ai][0][m][0][j], g1 = acc[ai][0][m][1][j];
                    h0[j] = g0 * __builtin_amdgcn_rcpf(1.0f + __expf(-g0)) * acc[ai][1][m][0][j];
                    h1[j] = g1 * __builtin_amdgcn_rcpf(1.0f + __expf(-g1)) * acc[ai][1][m][1][j];
                }
                u32x4 w; w.x = cvt_pk_bf16(h0[0], h0[1]); w.y = cvt_pk_bf16(h0[2], h0[3]); w.z = cvt_pk_bf16(h1[0], h1[1]); w.w = cvt_pk_bf16(h1[2], h1[3]);
                *(u32x4*)(rowp) = w;
            }
    }
};
struct EpiSwigluQ {
    static constexpr bool PERM = true, AFTER_DRAIN = false;
    bf16_t* H; const float* rowinv; const unsigned* wmax_bits;
    __device__ __forceinline__ void operator()(const i32x4 (&acc)[2][2][4][2], const Unit& u, int wr, int wc, int fr, int fq) const {
        const int row0 = u.pm * BM + wr * 64 + fr, col0 = u.pn * HALF + wc * 32 + 8 * fq;
        const float wdq = __builtin_bit_cast(float, *wmax_bits) * (1.0f / 127.0f);
#pragma unroll
        for (int ai = 0; ai < 2; ++ai)
#pragma unroll
            for (int m = 0; m < 4; ++m) {
                const int row = row0 + ai * HALF + m * 16;
                const float f = rowinv[row] * wdq;
                bf16_t* rowp = H + (size_t)row * 11008 + col0;
                f32x4 h0, h1;
#pragma unroll
                for (int j = 0; j < 4; ++j) {
                    const float g0 = (float)acc[ai][0][m][0][j] * f, g1 = (float)acc[ai][0][m][1][j] * f;
                    h0[j] = g0 * __builtin_amdgcn_rcpf(1.0f + __expf(-g0)) * ((float)acc[ai][1][m][0][j] * f);
                    h1[j] = g1 * __builtin_amdgcn_rcpf(1.0f + __expf(-g1)) * ((float)acc[ai][1][m][1][j] * f);
                }
                u32x4 w; w.x = cvt_pk_bf16(h0[0], h0[1]); w.y = cvt_pk_bf16(h0[2], h0[3]); w.z = cvt_pk_bf16(h1[0], h1[1]); w.w = cvt_pk_bf16(h1[2], h1[3]);
                *(u32x4*)(rowp) = w;
            }
    }
};
struct EpiResQ {
    static constexpr bool PERM = true, AFTER_DRAIN = false;
    bf16_t* X; float alpha; const float* rowinv; const unsigned* wmax_bits; const float* stats; const float* g; const float* b;
    __device__ __forceinline__ void operator()(const i32x4 (&acc)[2][2][4][2], const Unit& u, int wr, int wc, int fr, int fq) const {
        const int row0 = u.pm * BM + wr * 64 + fr, col0 = u.pn * BM + wc * 32 + 8 * fq;
        const float wdq = __builtin_bit_cast(float, *wmax_bits) * (1.0f / 127.0f);
#pragma unroll
        for (int ai = 0; ai < 2; ++ai) {
            u32x4 y[4][2]; float mean[4], rstd[4], f[4];
#pragma unroll
            for (int m = 0; m < 4; ++m) { const int row = row0 + ai * HALF + m * 16; const bf16_t* yp = X + (size_t)row * 4096 + col0; y[m][0] = *(const u32x4*)yp; y[m][1] = *(const u32x4*)(yp + HALF);
                mean[m] = stats[2 * row]; rstd[m] = stats[2 * row + 1]; f[m] = rowinv[row] * wdq; }
#pragma unroll
            for (int m = 0; m < 4; ++m) { bf16_t* rowp = X + (size_t)(row0 + ai * HALF + m * 16) * 4096 + col0;
#pragma unroll
                for (int bj = 0; bj < 2; ++bj) { const int c = col0 + bj * HALF; const float ra = rstd[m] * alpha;
                    const f32x4 g0 = *(const f32x4*)(g + c) * ra, g1 = *(const f32x4*)(g + c + 4) * ra, b0 = *(const f32x4*)(b + c) * alpha, b1 = *(const f32x4*)(b + c + 4) * alpha;
                    const i32x4 a0 = acc[ai][bj][m][0], a1 = acc[ai][bj][m][1];
                    f32x4 q0, q1; q0.x = (float)a0.x; q0.y = (float)a0.y; q0.z = (float)a0.z; q0.w = (float)a0.w; q1.x = (float)a1.x; q1.y = (float)a1.y; q1.z = (float)a1.z; q1.w = (float)a1.w;
                    *(u32x4*)(rowp + bj * HALF) = pk8h((h4lo(y[m][bj]) - mean[m]) * g0 + b0 + q0 * f[m], (h4hi(y[m][bj]) - mean[m]) * g1 + b1 + q1 * f[m]); } }
            asm volatile("" ::: "memory");
        }
    }
};
struct EpiProjV {
    static constexpr bool PERM = true, AFTER_DRAIN = false;
    bf16_t* O; const float* rope; const float* rowinv; const float* cmax;
    __device__ __forceinline__ void operator()(const i32x4 (&acc)[2][2][4][2], const Unit& u, int wr, int wc, int fr, int fq) const {
        const int pn = u.pn < 8 ? u.pn + 8 : u.pn + 16;
        const int row0 = u.pm * BM + wr * 64 + fr, col0 = pn * BM + wc * 32 + 8 * fq;
        const bool rot = (pn >= 24) && (pn < 40);
        const float ksc = (pn >= 32 && pn < 40) ? 0.0625f : 1.0f;
        f32x4 cs[2][2];
#pragma unroll
        for (int bj = 0; bj < 2; ++bj)
#pragma unroll
            for (int n = 0; n < 2; ++n) cs[bj][n] = *(const f32x4*)(cmax + col0 + bj * HALF + 4 * n) * (1.0f / 127.0f);
#pragma unroll
        for (int ai = 0; ai < 2; ++ai)
#pragma unroll
            for (int m = 0; m < 4; ++m) {
                const int row = row0 + ai * HALF + m * 16;
                const float rf = rowinv[row];
                bf16_t* rowp = O + (size_t)row * 14336 + col0;
                f32x4 q[2][2];
#pragma unroll
                for (int bj = 0; bj < 2; ++bj)
#pragma unroll
                    for (int n = 0; n < 2; ++n) { const i32x4 a = acc[ai][bj][m][n]; f32x4 t; t.x = (float)a.x; t.y = (float)a.y; t.z = (float)a.z; t.w = (float)a.w; q[bj][n] = t * rf * cs[bj][n]; }
                f32x4 a0 = q[0][0], a1 = q[0][1], b0 = q[1][0], b1 = q[1][1];
                if (rot) {
                    const int pos = row < 16384 ? (row & 2047) : (row - 16384);
                    const f32x4* rp = (const f32x4*)(rope + ((size_t)pos * 128 + wc * 32 + 8 * fq) * 2);
                    const f32x4 r0 = rp[0], r1 = rp[1], r2 = rp[2], r3 = rp[3];
                    const f32x4 c0 = {r0.x, r0.z, r1.x, r1.z}, s0 = {r0.y, r0.w, r1.y, r1.w}, c1 = {r2.x, r2.z, r3.x, r3.z}, s1 = {r2.y, r2.w, r3.y, r3.w};
                    const f32x4 na0 = a0 * c0 - b0 * s0, nb0 = a0 * s0 + b0 * c0, na1 = a1 * c1 - b1 * s1, nb1 = a1 * s1 + b1 * c1;
                    a0 = na0 * ksc; b0 = nb0 * ksc; a1 = na1 * ksc; b1 = nb1 * ksc;
                }
                *(u32x4*)(rowp) = pk8(a0, a1); *(u32x4*)(rowp + HALF) = pk8(b0, b1);
            }
    }
};
}

constexpr int NWAVES = 8, NT = 512;
#ifndef MK_N_LAUNCHES
#define MK_N_LAUNCHES 1
#endif
constexpr int DM = 4096, MTOK = 24576, NIN = 14336, DFF = 11008, NFF2 = 22016;
constexpr int C_AQ = 0, C_AK = 1024, C_AV = 2048, C_HY = 3072, C_RQ = 6144, C_RK = 8192, C_RV = 10240, C_RG = 12288;
constexpr float ALPHA = 1.4142135623730951f;
constexpr int NPH = 10;
constexpr int N_PHASES = 2 + 2 * NPH;
constexpr size_t MiB = 1u << 20;
constexpr size_t WS_CTL = 0, CTL_ZERO_BYTES = 1 * MiB;
constexpr size_t WS_ROPE = 1 * MiB;
constexpr size_t WS_H2 = 9 * MiB;
constexpr size_t WS_ROWINV = 14 * MiB;
constexpr size_t WS_TW = 15 * MiB;
constexpr size_t WS_ROWINV2 = 14 * MiB + 131072;
constexpr size_t WS_FMTAB = 15 * MiB + 262144;
constexpr size_t WS_STATS = 14 * MiB + 262144;
constexpr size_t WS_FSTAB = 15 * MiB + 524288;
constexpr size_t WS_XB = 16 * MiB;
constexpr size_t WS_WIN = 208 * MiB;
constexpr size_t WS_WOUT = 320 * MiB;
constexpr size_t WS_WFI = 352 * MiB;
constexpr size_t WS_WFO = 524 * MiB;
constexpr size_t WS_FILT = 610 * MiB;
constexpr size_t WS_PROJ = 770 * MiB;
constexpr size_t WS_MIXED = 1442 * MiB;
constexpr size_t WS_HYT = 1634 * MiB;
constexpr size_t WS_ST = 1922 * MiB;
constexpr size_t WS_HQ = WS_MIXED;
constexpr size_t WS_ZOUT = 2306 * MiB;
constexpr size_t WS_FS = 2402 * MiB;
constexpr size_t WS_XR = 2410 * MiB;
constexpr size_t WS_XQ = 2602 * MiB;
constexpr size_t WS_WINQ = 2698 * MiB;
constexpr size_t WS_ROWINV3 = 14 * MiB + 524288;
constexpr size_t WS_END = 2746 * MiB;
constexpr int NB16 = 16 * 256, NQN = 40 * 256;

constexpr size_t FILT_L1_OFF = (size_t)2 * 1024 * 4096;
constexpr int CW_BAR = 4096;
constexpr int CW_CMAX = 32768;
constexpr int CW_WMAX = 2048;
constexpr int LDS_BYTES = 151552;
constexpr int MISC_OFF = 147456;

#define GAS __attribute__((address_space(1)))
#define LAS __attribute__((address_space(3)))
typedef unsigned short bf16;
typedef unsigned v4u __attribute__((ext_vector_type(4)));
typedef unsigned v2u __attribute__((ext_vector_type(2)));
typedef float f32x4 __attribute__((ext_vector_type(4)));
typedef float f32x2 __attribute__((ext_vector_type(2)));
typedef short bf16x8 __attribute__((ext_vector_type(8)));
typedef short s16x4 __attribute__((ext_vector_type(4)));
__device__ __forceinline__ unsigned f2bf(float f) { unsigned u = __builtin_bit_cast(unsigned, f); return (u + 0x7fffu + ((u >> 16) & 1u)) >> 16; }
typedef __bf16 bf16x2_t __attribute__((ext_vector_type(2)));
__device__ __forceinline__ unsigned pk2(float lo, float hi) { const f32x2 v = {lo, hi}; return __builtin_bit_cast(unsigned, __builtin_convertvector(v, bf16x2_t)); }
__device__ __forceinline__ float bflo(unsigned w) { return __builtin_bit_cast(float, w << 16); }
__device__ __forceinline__ float bfhi(unsigned w) { return __builtin_bit_cast(float, w & 0xffff0000u); }
__device__ __forceinline__ s16x4 tr16(const LAS unsigned char* p) { return __builtin_bit_cast(s16x4, __builtin_amdgcn_ds_read_tr16_b64_v4i16((LAS s16x4*)p)); }
__device__ __forceinline__ bf16x8 cat8(s16x4 lo, s16x4 hi) { return __builtin_shufflevector(lo, hi, 0, 1, 2, 3, 4, 5, 6, 7); }
__device__ __forceinline__ f32x4 mfma16(bf16x8 a, bf16x8 b, f32x4 c) { return __builtin_amdgcn_mfma_f32_16x16x32_bf16(a, b, c, 0, 0, 0); }
#define LDS_WAIT() asm volatile("s_waitcnt lgkmcnt(0)" ::: "memory")
__device__ __forceinline__ float wave_sum(float v) {
#pragma unroll
    for (int o = 1; o < 64; o <<= 1) v += __shfl_xor(v, o);
    return v;
}
#define XB_TMO      128
#define XB_XCNT(j)  (256  + 64 * (j))
#define XB_XSUB(j)  (1280 + 64 * (j))
#define XB_XGEN(j)  (2304 + 64 * (j))
#define XB_TOP      3328
#define XB_TOPGEN   3392
#define XCD_BAR_WORDS 3456
#define XB_SPIN_CAP (1u << 18)

__device__ __forceinline__ unsigned xb_ld(unsigned* p)              { return __hip_atomic_load(p, __ATOMIC_RELAXED, __HIP_MEMORY_SCOPE_AGENT); }
__device__ __forceinline__ unsigned xb_add(unsigned* p, unsigned v) { return __hip_atomic_fetch_add(p, v, __ATOMIC_RELAXED, __HIP_MEMORY_SCOPE_AGENT); }
__device__ __forceinline__ unsigned xb_xcc_id() { return (unsigned)__builtin_amdgcn_s_getreg((3 << 11) | 20) & 0xFu; }
#define XB_SPIN(cond, bar) do { unsigned _sp = 0; while (cond) { __builtin_amdgcn_s_sleep(1); \
    if ((++_sp & 255u) == 0u) { if (xb_ld(&(bar)[XB_TMO])) break; if (_sp > XB_SPIN_CAP) { atomicAdd(&(bar)[XB_TMO], 1u); break; } } } } while (0)

struct XcdBarrier {
    unsigned* bar; unsigned x;
    volatile LAS unsigned* st;
};

__device__ __forceinline__ XcdBarrier xcd_barrier_post(unsigned* bar, volatile LAS unsigned* st) {
    XcdBarrier b; b.bar = bar; b.x = xb_xcc_id(); b.st = st;
    if (threadIdx.x == 0) (void)xb_add(&bar[XB_XCNT(b.x)], 1u);
    return b;
}
__device__ __forceinline__ void xcd_barrier_complete(unsigned* bar, unsigned x, unsigned& nloc, unsigned& nx) {
    const unsigned G = gridDim.x * gridDim.y * gridDim.z;
    unsigned sum, cnt, mine, sp = 0u;
    for (;;) {
        sum = 0u; cnt = 0u; mine = 0u;
#pragma unroll
        for (unsigned j = 0; j < 16; ++j) { const unsigned c = xb_ld(&bar[XB_XCNT(j)]); sum += c; cnt += (c > 0u) ? 1u : 0u; mine = (j == x) ? c : mine; }
        if (sum == G) break;
        __builtin_amdgcn_s_sleep(1);
        if ((++sp & 255u) == 0u) { if (xb_ld(&bar[XB_TMO])) break; if (sp > XB_SPIN_CAP) { atomicAdd(&bar[XB_TMO], 1u); break; } }
    }
    nloc = mine > 0u ? mine : 1u; nx = cnt > 0u ? cnt : 1u;
}

__device__ __forceinline__ void xcd_barrier(const XcdBarrier& b) {
    asm volatile("s_waitcnt vmcnt(0)" ::: "memory");
    __syncthreads();
    if (threadIdx.x == 0) {
        unsigned* bar = b.bar;
        __builtin_amdgcn_s_waitcnt(0);
        unsigned nloc = b.st[0], nx = b.st[1];
        if (nloc == 0u) { xcd_barrier_complete(bar, b.x, nloc, nx); b.st[0] = nloc; b.st[1] = nx; }
        const unsigned old = xb_add(&bar[XB_XSUB(b.x)], 1u);
        const unsigned gen = old / nloc;
        if (old + 1u == (gen + 1u) * nloc) {
            __builtin_amdgcn_fence(__ATOMIC_RELEASE, "agent");
            asm volatile("s_waitcnt vmcnt(0)" ::: "memory");
            const unsigned og = xb_add(&bar[XB_TOP], 1u);
            const unsigned tg = og / nx;
            if (og + 1u == (tg + 1u) * nx) xb_add(&bar[XB_TOPGEN], 1u);
            else XB_SPIN(xb_ld(&bar[XB_TOPGEN]) == tg, bar);
            __builtin_amdgcn_fence(__ATOMIC_ACQUIRE, "agent");
            xb_add(&bar[XB_XGEN(b.x)], 1u);
            asm volatile("s_waitcnt vmcnt(0)" ::: "memory");
        } else {
            XB_SPIN(xb_ld(&bar[XB_XGEN(b.x)]) == gen, bar);
            __builtin_amdgcn_fence(__ATOMIC_ACQUIRE, "agent");
            asm volatile("s_waitcnt vmcnt(0)" ::: "memory");
        }
    }
    __syncthreads();
}

__device__ __forceinline__ void transpose_item(const float* W, int K, int N, bf16* WT, int k0, int n0, int drow0, LAS float* scr, int lane) {
#pragma unroll 16
    for (int i = 0; i < 32; ++i) { const int kk = 2 * i + (lane >> 5); scr[kk * 33 + (lane & 31)] = __builtin_nontemporal_load(W + (size_t)(k0 + kk) * N + n0 + (lane & 31)); }
    LDS_WAIT();
    const int c = lane & 7;
#pragma unroll
    for (int j = 0; j < 4; ++j) { const int n = (lane >> 3) + 8 * j; const LAS float* s = scr + (8 * c) * 33 + n;
        v4u o; o.x = pk2(s[0 * 33], s[1 * 33]); o.y = pk2(s[2 * 33], s[3 * 33]); o.z = pk2(s[4 * 33], s[5 * 33]); o.w = pk2(s[6 * 33], s[7 * 33]);
        *(v4u*)(WT + (size_t)(drow0 + n) * K + k0 + 8 * c) = o; }
    LDS_WAIT();
}
__device__ __forceinline__ void transpose_item_h(const float* W, int K, int N, bf16* WT, int k0, int n0, int drow0, LAS float* scr, int lane) {
#pragma unroll 16
    for (int i = 0; i < 32; ++i) { const int kk = 2 * i + (lane >> 5); scr[kk * 33 + (lane & 31)] = __builtin_nontemporal_load(W + (size_t)(k0 + kk) * N + n0 + (lane & 31)); }
    LDS_WAIT();
    const int c = lane & 7;
#pragma unroll
    for (int j = 0; j < 4; ++j) { const int n = (lane >> 3) + 8 * j; const LAS float* s = scr + (8 * c) * 33 + n;
        v4u o; o.x = pg8::pkh(s[0 * 33], s[1 * 33]); o.y = pg8::pkh(s[2 * 33], s[3 * 33]); o.z = pg8::pkh(s[4 * 33], s[5 * 33]); o.w = pg8::pkh(s[6 * 33], s[7 * 33]);
        *(v4u*)(WT + (size_t)(drow0 + n) * K + k0 + 8 * c) = o; }
    LDS_WAIT();
}
__device__ __forceinline__ void transpose_item_q(const float* W, int K, int N, signed char* WT, int k0, int n0, int drow0, float sw, LAS float* scr, int lane) {
#pragma unroll 16
    for (int i = 0; i < 32; ++i) { const int kk = 2 * i + (lane >> 5); scr[kk * 33 + (lane & 31)] = __builtin_nontemporal_load(W + (size_t)(k0 + kk) * N + n0 + (lane & 31)); }
    LDS_WAIT();
    const int n = lane >> 1, hf = lane & 1; const LAS float* s = scr + (hf * 32) * 33 + n;
    unsigned o[8];
#pragma unroll
    for (int d = 0; d < 8; ++d) { unsigned w = 0;
#pragma unroll
        for (int b = 0; b < 4; ++b) { const float q = fminf(fmaxf(rintf(s[(4 * d + b) * 33] * sw), -127.f), 127.f); w |= ((unsigned)(int)q & 0xffu) << (8 * b); }
        o[d] = w; }
    v4u* dst = (v4u*)(WT + (size_t)(drow0 + n) * K + k0 + hf * 32);
    dst[0] = (v4u){o[0], o[1], o[2], o[3]}; dst[1] = (v4u){o[4], o[5], o[6], o[7]};
    LDS_WAIT();
}
__device__ __forceinline__ void transpose_item_qc(const float* W, int K, int N, signed char* WT, int k0, int n0, int drow0, const unsigned* colmax_bits, LAS float* scr, int lane) {
#pragma unroll 16
    for (int i = 0; i < 32; ++i) { const int kk = 2 * i + (lane >> 5); scr[kk * 33 + (lane & 31)] = __builtin_nontemporal_load(W + (size_t)(k0 + kk) * N + n0 + (lane & 31)); }
    LDS_WAIT();
    const int n = lane >> 1, hf = lane & 1; const LAS float* s = scr + (hf * 32) * 33 + n;
    const float sw = 127.0f / fmaxf(__builtin_bit_cast(float, colmax_bits[n0 + n]), 1e-30f);
    unsigned o[8];
#pragma unroll
    for (int dd = 0; dd < 8; ++dd) { unsigned w = 0;
#pragma unroll
        for (int b = 0; b < 4; ++b) { const float q = fminf(fmaxf(rintf(s[(4 * dd + b) * 33] * sw), -127.f), 127.f); w |= ((unsigned)(int)q & 0xffu) << (8 * b); }
        o[dd] = w; }
    v4u* dst = (v4u*)(WT + (size_t)(drow0 + n) * K + k0 + hf * 32);
    dst[0] = (v4u){o[0], o[1], o[2], o[3]}; dst[1] = (v4u){o[4], o[5], o[6], o[7]};
    LDS_WAIT();
}
__device__ __forceinline__ void colmax_f32(const float* W, int K, int ld, int ncols, unsigned* dst, int gw, int ngw, int lane) {
    const int nb = ncols / 256;
    for (int it = gw; it < (K / 64) * nb; it += ngw) { const int kb = it / nb, cb = it % nb; const float* p = W + (size_t)(kb * 64) * ld + cb * 256 + lane * 4; f32x4 m = {0.f, 0.f, 0.f, 0.f};
#pragma unroll 16
        for (int k = 0; k < 64; ++k) { const f32x4 v = __builtin_nontemporal_load((const f32x4*)(p + (size_t)k * ld)); m.x = fmaxf(m.x, fabsf(v.x)); m.y = fmaxf(m.y, fabsf(v.y)); m.z = fmaxf(m.z, fabsf(v.z)); m.w = fmaxf(m.w, fabsf(v.w)); }
        unsigned* d = dst + cb * 256 + lane * 4;
        atomicMax(d, __builtin_bit_cast(unsigned, m.x + 0.f)); atomicMax(d + 1, __builtin_bit_cast(unsigned, m.y + 0.f)); atomicMax(d + 2, __builtin_bit_cast(unsigned, m.z + 0.f)); atomicMax(d + 3, __builtin_bit_cast(unsigned, m.w + 0.f)); }
}
__device__ __forceinline__ void absmax_f32(const float* w, size_t n4, unsigned* dst, size_t gtid, size_t nthr, int lane) {
    float m = 0.f;
    size_t i = gtid;
    for (; i + 7 * nthr < n4; i += 8 * nthr) { f32x4 v[8];
#pragma unroll
        for (int j = 0; j < 8; ++j) v[j] = __builtin_nontemporal_load((const f32x4*)w + i + j * nthr);
#pragma unroll
        for (int j = 0; j < 8; ++j) m = fmaxf(fmaxf(m, fmaxf(fabsf(v[j].x), fabsf(v[j].y))), fmaxf(fabsf(v[j].z), fabsf(v[j].w))); }
    for (; i < n4; i += nthr) { const f32x4 v = ((const f32x4*)w)[i]; m = fmaxf(fmaxf(m, fmaxf(fabsf(v.x), fabsf(v.y))), fmaxf(fabsf(v.z), fabsf(v.w))); }
#pragma unroll
    for (int o = 1; o < 64; o <<= 1) m = fmaxf(m, __shfl_xor(m, o));
    if (lane == 0) atomicMax(dst, __builtin_bit_cast(unsigned, m));
}
__device__ __forceinline__ void ln_row_q(const float* src, const float* g, const float* b, signed char* dstq, float* rowinv, float* stat, int lane) {
    const f32x4* xr = (const f32x4*)src + lane;
    f32x4 v[16]; float s = 0.f;
#pragma unroll
    for (int j = 0; j < 16; ++j) { v[j] = xr[64 * j]; s += (v[j].x + v[j].y) + (v[j].z + v[j].w); }
    const float mean = wave_sum(s) * (1.f / 4096.f); float s2 = 0.f;
#pragma unroll
    for (int j = 0; j < 16; ++j) { v[j] = v[j] - mean; s2 += (v[j].x * v[j].x + v[j].y * v[j].y) + (v[j].z * v[j].z + v[j].w * v[j].w); }
    const float rstd = 1.f / sqrtf(wave_sum(s2) * (1.f / 4096.f) + 1e-5f);
    if (lane == 0) { stat[0] = mean; stat[1] = rstd; }
    float mx = 0.f;
#pragma unroll
    for (int j = 0; j < 16; ++j) {
        const f32x4 gg = ((const f32x4*)g)[64 * j + lane], bb = ((const f32x4*)b)[64 * j + lane];
        v[j] = v[j] * rstd * gg + bb;
        mx = fmaxf(fmaxf(mx, fmaxf(fabsf(v[j].x), fabsf(v[j].y))), fmaxf(fabsf(v[j].z), fabsf(v[j].w)));
    }
#pragma unroll
    for (int o = 1; o < 64; o <<= 1) mx = fmaxf(mx, __shfl_xor(mx, o));
    mx = fmaxf(mx, 1e-20f);
    const float sc = 127.0f / mx;
    if (lane == 0) *rowinv = mx * (1.0f / 127.0f);
#pragma unroll
    for (int j = 0; j < 16; ++j) {
        const unsigned w = ((unsigned)(int)rintf(v[j].x * sc) & 0xffu) | (((unsigned)(int)rintf(v[j].y * sc) & 0xffu) << 8) | (((unsigned)(int)rintf(v[j].z * sc) & 0xffu) << 16) | (((unsigned)(int)rintf(v[j].w * sc) & 0xffu) << 24);
        ((unsigned*)dstq)[64 * j + lane] = w;
    }
}
__device__ __forceinline__ void ln_load_b(const bf16* src, f32x4 (&v)[16], float& mean, float& rstd, int lane) {
    const v4u* xr = (const v4u*)src + lane; float s = 0.f;
#pragma unroll
    for (int j = 0; j < 8; ++j) { const v4u w = xr[64 * j]; v[2 * j] = pg8::h4lo(w); v[2 * j + 1] = pg8::h4hi(w);
        s += ((v[2 * j].x + v[2 * j].y) + (v[2 * j].z + v[2 * j].w)) + ((v[2 * j + 1].x + v[2 * j + 1].y) + (v[2 * j + 1].z + v[2 * j + 1].w)); }
    mean = wave_sum(s) * (1.f / 4096.f); float s2 = 0.f;
#pragma unroll
    for (int j = 0; j < 16; ++j) { v[j] = v[j] - mean; s2 += (v[j].x * v[j].x + v[j].y * v[j].y) + (v[j].z * v[j].z + v[j].w * v[j].w); }
    rstd = 1.f / sqrtf(wave_sum(s2) * (1.f / 4096.f) + 1e-5f);
}
__device__ __forceinline__ void ln_row_qb(const bf16* src, const float* g, const float* b, signed char* dstq, float* rowinv, float* stat, int lane) {
    f32x4 v[16]; float mean, rstd; ln_load_b(src, v, mean, rstd, lane);
    if (lane == 0) { stat[0] = mean; stat[1] = rstd; }
    float mx = 0.f;
#pragma unroll
    for (int j = 0; j < 16; ++j) {
        const int q = 2 * (64 * (j >> 1) + lane) + (j & 1);
        const f32x4 gg = ((const f32x4*)g)[q], bb = ((const f32x4*)b)[q];
        v[j] = v[j] * rstd * gg + bb;
        mx = fmaxf(fmaxf(mx, fmaxf(fabsf(v[j].x), fabsf(v[j].y))), fmaxf(fabsf(v[j].z), fabsf(v[j].w)));
    }
#pragma unroll
    for (int o = 1; o < 64; o <<= 1) mx = fmaxf(mx, __shfl_xor(mx, o));
    mx = fmaxf(mx, 1e-20f);
    const float sc = 127.0f / mx;
    if (lane == 0) *rowinv = mx * (1.0f / 127.0f);
#pragma unroll
    for (int j = 0; j < 8; ++j) { v2u w;
        w.x = ((unsigned)(int)rintf(v[2 * j].x * sc) & 0xffu) | (((unsigned)(int)rintf(v[2 * j].y * sc) & 0xffu) << 8) | (((unsigned)(int)rintf(v[2 * j].z * sc) & 0xffu) << 16) | (((unsigned)(int)rintf(v[2 * j].w * sc) & 0xffu) << 24);
        w.y = ((unsigned)(int)rintf(v[2 * j + 1].x * sc) & 0xffu) | (((unsigned)(int)rintf(v[2 * j + 1].y * sc) & 0xffu) << 8) | (((unsigned)(int)rintf(v[2 * j + 1].z * sc) & 0xffu) << 16) | (((unsigned)(int)rintf(v[2 * j + 1].w * sc) & 0xffu) << 24);
        ((v2u*)dstq)[64 * j + lane] = w; }
}
template <bool WF> __device__ __forceinline__ void ln_row_b(const bf16* src, const float* g, const float* b, float* dstf, bf16* dstb, int lane) {
    f32x4 v[16]; float mean, rstd; ln_load_b(src, v, mean, rstd, lane);
#pragma unroll
    for (int j = 0; j < 8; ++j) { const int q = 2 * (64 * j + lane);
        const f32x4 o0 = v[2 * j] * rstd * ((const f32x4*)g)[q] + ((const f32x4*)b)[q], o1 = v[2 * j + 1] * rstd * ((const f32x4*)g)[q + 1] + ((const f32x4*)b)[q + 1];
        if (WF) { ((f32x4*)dstf)[q] = o0; ((f32x4*)dstf)[q + 1] = o1; }
        else { v4u w; w.x = pk2(o0.x, o0.y); w.y = pk2(o0.z, o0.w); w.z = pk2(o1.x, o1.y); w.w = pk2(o1.z, o1.w); ((v4u*)dstb)[64 * j + lane] = w; } }
}
__device__ __forceinline__ void quant_row_h(const bf16* src, signed char* dst, float* rowinv, int lane) {
    v4u x[22]; float mx = 0.f;
#pragma unroll
    for (int i = 0; i < 22; ++i) { const int id = lane + 64 * i; x[i] = id < 1376 ? __builtin_nontemporal_load((const v4u*)src + id) : (v4u){0u, 0u, 0u, 0u};
        mx = fmaxf(mx, fmaxf(fmaxf(fmaxf(fabsf(bflo(x[i].x)), fabsf(bfhi(x[i].x))), fmaxf(fabsf(bflo(x[i].y)), fabsf(bfhi(x[i].y)))), fmaxf(fmaxf(fabsf(bflo(x[i].z)), fabsf(bfhi(x[i].z))), fmaxf(fabsf(bflo(x[i].w)), fabsf(bfhi(x[i].w)))))); }
#pragma unroll
    for (int o = 1; o < 64; o <<= 1) mx = fmaxf(mx, __shfl_xor(mx, o));
    mx = fmaxf(mx, 1e-20f);
    const float sc = 127.0f / mx;
    if (lane == 0) *rowinv = mx * (1.0f / 127.0f);
#pragma unroll
    for (int i = 0; i < 22; ++i) { const int id = lane + 64 * i;
        if (id < 1376) { v2u w;
            w.x = ((unsigned)(int)rintf(bflo(x[i].x) * sc) & 0xffu) | (((unsigned)(int)rintf(bfhi(x[i].x) * sc) & 0xffu) << 8) | (((unsigned)(int)rintf(bflo(x[i].y) * sc) & 0xffu) << 16) | (((unsigned)(int)rintf(bfhi(x[i].y) * sc) & 0xffu) << 24);
            w.y = ((unsigned)(int)rintf(bflo(x[i].z) * sc) & 0xffu) | (((unsigned)(int)rintf(bfhi(x[i].z) * sc) & 0xffu) << 8) | (((unsigned)(int)rintf(bflo(x[i].w) * sc) & 0xffu) << 16) | (((unsigned)(int)rintf(bfhi(x[i].w) * sc) & 0xffu) << 24);
            ((v2u*)dst)[id] = w; } }
}
__device__ __forceinline__ void convert_weights(const float* w_in, const float* w_out, const float* w_fi, const float* w_fo, unsigned char* ws, const unsigned* wmax_bits, const unsigned* cmax_bits, LAS unsigned char* lds, int gw, int ngw, int wave, int lane) {
    const float sw = 127.0f / fmaxf(__builtin_bit_cast(float, wmax_bits[0]), 1e-30f), sw2 = 127.0f / fmaxf(__builtin_bit_cast(float, wmax_bits[2]), 1e-30f);
    LAS float* scr = (LAS float*)(lds + wave * 8704);
    constexpr int I_IN = 64 * 448, I_OUT = 64 * 128, I_FI = 64 * 688, I_FO = 172 * 128;
    for (int it = gw; it < I_IN + I_OUT + I_FI + I_FO; it += ngw) {
        int r = it;
        if (r < I_IN) { const int kb = r / 448, nb = r % 448;
            const int n0 = nb * 32, pn = n0 >> 8, nin = n0 & 255;
            if ((pn >= 8 && pn < 16) || pn >= 24) transpose_item_qc(w_in, 4096, NIN, (signed char*)(ws + WS_WINQ), kb * 64, n0, (pn < 16 ? pn - 8 : pn - 16) * 256 + nin, cmax_bits, scr, lane);
            else transpose_item_h(w_in, 4096, NIN, (bf16*)(ws + WS_WIN), kb * 64, n0, (pn < 8 ? pn : pn - 8) * 256 + nin, scr, lane);
            continue; } r -= I_IN;
        if (r < I_OUT) { const int kb = r / 128, nb = r % 128; transpose_item(w_out, 4096, 4096, (bf16*)(ws + WS_WOUT), kb * 64, nb * 32, nb * 32, scr, lane); continue; } r -= I_OUT;
        if (r < I_FI) { const int kb = r / 688, nb = r % 688, n0 = nb * 32, bj = n0 >= DFF ? 1 : 0, rem = n0 - bj * DFF;
            transpose_item_q(w_fi, 4096, NFF2, (signed char*)(ws + WS_WFI), kb * 64, n0, 256 * (rem >> 7) + 128 * bj + (rem & 127), sw, scr, lane); continue; } r -= I_FI;
        { const int kb = r / 128, nb = r % 128; transpose_item_q(w_fo, DFF, 4096, (signed char*)(ws + WS_WFO), kb * 64, nb * 32, nb * 32, sw2, scr, lane); }
    }
}
template <bool WF> __device__ __forceinline__ void ln_row(const float* src, const float* g, const float* b, float* dstf, bf16* dstb, float* stat, int lane) {
    const f32x4* xr = (const f32x4*)src + lane;
    f32x4 v[16]; float s = 0.f;
#pragma unroll
    for (int j = 0; j < 16; ++j) { v[j] = xr[64 * j]; s += (v[j].x + v[j].y) + (v[j].z + v[j].w); }
    const float mean = wave_sum(s) * (1.f / 4096.f); float s2 = 0.f;
#pragma unroll
    for (int j = 0; j < 16; ++j) { v[j] = v[j] - mean; s2 += (v[j].x * v[j].x + v[j].y * v[j].y) + (v[j].z * v[j].z + v[j].w * v[j].w); }
    const float rstd = 1.f / sqrtf(wave_sum(s2) * (1.f / 4096.f) + 1e-5f);
    if (!WF && lane == 0) { stat[0] = mean; stat[1] = rstd; }
#pragma unroll
    for (int j = 0; j < 16; ++j) {
        const f32x4 gg = ((const f32x4*)g)[64 * j + lane], bb = ((const f32x4*)b)[64 * j + lane];
        const f32x4 o = v[j] * rstd * gg + bb;
        if (WF) ((f32x4*)dstf)[64 * j + lane] = o;
        if (dstb) { v2u w; w.x = pk2(o.x, o.y); w.y = pk2(o.z, o.w); ((v2u*)dstb)[64 * j + lane] = w; }
    }
}
template <bool PAIR> __device__ __forceinline__ void row_quant(const f32x4 (&v)[16], signed char* dstq, float* rowinv, int lane) {
    float mx = 0.f;
#pragma unroll
    for (int j = 0; j < 16; ++j) mx = fmaxf(fmaxf(mx, fmaxf(fabsf(v[j].x), fabsf(v[j].y))), fmaxf(fabsf(v[j].z), fabsf(v[j].w)));
#pragma unroll
    for (int o = 1; o < 64; o <<= 1) mx = fmaxf(mx, __shfl_xor(mx, o));
    mx = fmaxf(mx, 1e-20f);
    const float sc = 127.0f / mx;
    if (lane == 0) *rowinv = mx * (1.0f / 127.0f);
    unsigned w[16];
#pragma unroll
    for (int j = 0; j < 16; ++j) w[j] = ((unsigned)(int)rintf(v[j].x * sc) & 0xffu) | (((unsigned)(int)rintf(v[j].y * sc) & 0xffu) << 8) | (((unsigned)(int)rintf(v[j].z * sc) & 0xffu) << 16) | (((unsigned)(int)rintf(v[j].w * sc) & 0xffu) << 24);
    if (PAIR) {
#pragma unroll
        for (int j = 0; j < 8; ++j) ((v2u*)dstq)[64 * j + lane] = (v2u){w[2 * j], w[2 * j + 1]};
    } else {
#pragma unroll
        for (int j = 0; j < 16; ++j) ((unsigned*)dstq)[64 * j + lane] = w[j];
    }
}
__device__ __forceinline__ void ln_row_in(const float* src, const float* g, const float* b, bf16* dstb, signed char* dstq, float* rowinv, int lane) {
    const f32x4* xr = (const f32x4*)src + lane;
    f32x4 v[16]; float s = 0.f;
#pragma unroll
    for (int j = 0; j < 16; ++j) { v[j] = __builtin_nontemporal_load(xr + 64 * j); s += (v[j].x + v[j].y) + (v[j].z + v[j].w); }
    const float mean = wave_sum(s) * (1.f / 4096.f); float s2 = 0.f;
#pragma unroll
    for (int j = 0; j < 16; ++j) { v[j] = v[j] - mean; s2 += (v[j].x * v[j].x + v[j].y * v[j].y) + (v[j].z * v[j].z + v[j].w * v[j].w); }
    const float rstd = 1.f / sqrtf(wave_sum(s2) * (1.f / 4096.f) + 1e-5f);
#pragma unroll
    for (int j = 0; j < 16; ++j) {
        const f32x4 gg = ((const f32x4*)g)[64 * j + lane], bb = ((const f32x4*)b)[64 * j + lane];
        v[j] = v[j] * rstd * gg + bb;
        v2u w; w.x = pg8::pkh(v[j].x, v[j].y); w.y = pg8::pkh(v[j].z, v[j].w); ((v2u*)dstb)[64 * j + lane] = w;
    }
    row_quant<false>(v, dstq, rowinv, lane);
}
__device__ __forceinline__ void ln_row_b_in(const bf16* src, const float* g, const float* b, bf16* dstb, signed char* dstq, float* rowinv, int lane) {
    f32x4 v[16]; float mean, rstd; ln_load_b(src, v, mean, rstd, lane);
#pragma unroll
    for (int j = 0; j < 8; ++j) { const int q = 2 * (64 * j + lane);
        v[2 * j] = v[2 * j] * rstd * ((const f32x4*)g)[q] + ((const f32x4*)b)[q]; v[2 * j + 1] = v[2 * j + 1] * rstd * ((const f32x4*)g)[q + 1] + ((const f32x4*)b)[q + 1];
        v4u w; w.x = pg8::pkh(v[2 * j].x, v[2 * j].y); w.y = pg8::pkh(v[2 * j].z, v[2 * j].w); w.z = pg8::pkh(v[2 * j + 1].x, v[2 * j + 1].y); w.w = pg8::pkh(v[2 * j + 1].z, v[2 * j + 1].w); ((v4u*)dstb)[64 * j + lane] = w; }
    row_quant<true>(v, dstq, rowinv, lane);
}
__device__ __forceinline__ void pre_tables(const float* w1a, const float* b1a, const float* fqa, const float* w2a, const float* b2a, unsigned char* ws, int gw, int ngw, int lane) {
    float* rope = (float*)(ws + WS_ROPE);
    for (int i = gw * 64 + lane; i < 8192 * 128; i += ngw * 64) {
        const int pos = i >> 7, j = i & 127;
        const float inv = 1.0f / powf(10000.0f, (float)j * (1.0f / 127.0f));
        const float ang = (float)pos * inv;
        rope[2 * i] = cosf(ang); rope[2 * i + 1] = sinf(ang);
    }
    { float* tw = (float*)(ws + WS_TW);
      for (int j = gw * 64 + lane; j < 16384; j += ngw * 64) { float sn, cs; sincospif(-2.0f * (float)j / 16384.0f, &sn, &cs); tw[2 * j] = cs; tw[2 * j + 1] = sn; } }
    float* H2 = (float*)(ws + WS_H2);
    for (int it = gw; it < 2 * 10240; it += ngw) {
        const int l = it / 10240, r = it % 10240, Lidx = r >= 2048 ? 1 : 0, t = Lidx ? r - 2048 : r, L = Lidx ? 8192 : 2048;
        const float* w1 = w1a + l * 33 * 64; const float* b1 = b1a + l * 64; const float* fq = fqa + l * 128; const float* w2 = w2a + l * 64 * 64; const float* b2 = b2a + l * 64;
        float z = 0.f;
        if (lane == 0) z = (float)t / (float)(L - 1);
        else if (lane < 33) { const int i = (lane - 1) & 15; const float sfr = (float)i / 15.0f; const float fr = 1e-4f * (1.0f - sfr) + 15.0f * sfr;
            const float wpos = (6.283185307179586f * (float)t) / (float)L; const float a = fr * wpos; z = lane < 17 ? cosf(a) : -sinf(a); }
        float p1 = b1[lane];
        for (int e = 0; e < 33; ++e) p1 += __shfl(z, e) * w1[e * 64 + lane];
        const float h1 = sinf(fq[lane] * p1);
        float p2 = b2[lane];
        for (int j = 0; j < 64; ++j) p2 += __shfl(h1, j) * w2[j * 64 + lane];
        H2[(size_t)it * 64 + lane] = sinf(fq[64 + lane] * p2);
    }
}
__device__ __forceinline__ void filter_assembly(const float* w3, const float* b3, const float* skip, const float* H2l, float* FILT, LAS unsigned char* lds, int vb, int nb, int tid, int wave, int lane) {
    LAS float* Hs = (LAS float*)lds;
    LAS float* tile = (LAS float*)(lds + 8192 + wave * 8448);
    constexpr int U0 = 2 * 2 * 64, U1 = 2 * 2 * 256;
    for (int it = vb; it < U0 + U1; it += nb) {
        const int Lidx = it >= U0 ? 1 : 0, r = Lidx ? it - U0 : it, L = Lidx ? 8192 : 2048, ntt = L / 32;
        const int tt = r % ntt, dir = (r / ntt) & 1, o = r / (ntt * 2);
        __syncthreads();
        ((LAS f32x4*)Hs)[tid] = ((const f32x4*)(H2l + (size_t)((Lidx ? 2048 : 0) + tt * 32) * 64))[tid];
        __syncthreads();
#pragma unroll 1
        for (int ci = 0; ci < 2; ++ci) {
            const int cg = wave + 8 * ci;
            const int x = lane & 15, g = lane >> 4;
            float av[2][16];
#pragma unroll
            for (int t2 = 0; t2 < 2; ++t2)
#pragma unroll
                for (int kk = 0; kk < 16; ++kk) av[t2][kk] = Hs[(16 * t2 + x) * 64 + 4 * kk + g];
#pragma unroll 1
            for (int ct = 0; ct < 4; ++ct) {
                const int c = cg * 64 + ct * 16 + x, col = (o * 2 + dir) * 1024 + c;
                float bw[16];
#pragma unroll
                for (int kk = 0; kk < 16; ++kk) bw[kk] = w3[(4 * kk + g) * 4096 + col];
                const float bias = b3[col];
                const float delta = fabsf(-3.0701134573253945f + (float)c * ((-15.350567286626973f + 3.0701134573253945f) / 1023.0f));
                const float sk = skip[o * 1024 + c];
#pragma unroll
                for (int t2 = 0; t2 < 2; ++t2) {
                    f32x4 acc = {0.f, 0.f, 0.f, 0.f};
#pragma unroll
                    for (int kk = 0; kk < 16; ++kk) acc = __builtin_amdgcn_mfma_f32_16x16x4f32(av[t2][kk], bw[kk], acc, 0, 0, 0);
#pragma unroll
                    for (int e = 0; e < 4; ++e) { const int tl = 16 * t2 + 4 * g + e, t = tt * 32 + tl;
                        float a = (acc[e] + bias) * expf(-((float)t / (float)(L - 1)) * delta);
                        if (dir == 0 && t == 0) a += sk;
                        if (dir == 1 && t == 0) a = 0.f;
                        tile[(ct * 16 + x) * 33 + tl] = a; }
                }
            }
            LDS_WAIT();
            float* Fb = FILT + (Lidx ? FILT_L1_OFF : 0) + ((size_t)o * 1024 + cg * 64) * (size_t)(2 * L);
            const int t = tt * 32 + (lane & 31);
            const int p = dir == 0 ? t : (t == 0 ? L : 2 * L - t);
#pragma unroll 8
            for (int c2 = 0; c2 < 32; ++c2) { const int cc = 2 * c2 + (lane >> 5); Fb[(size_t)cc * (2 * L) + p] = tile[cc * 33 + (lane & 31)]; }
            LDS_WAIT();
        }
    }
    __syncthreads();
}
__device__ __forceinline__ void hyena_transpose(const bf16* proj, const float* cw, const float* cb, float* HYT, LAS unsigned char* lds, int gw, int ngw, int wave, int lane_in) {
    for (int it = gw; it < 3 * 16 * 384; it += ngw) {
        int lane = lane_in; asm volatile("" : "+v"(lane));
        const int tl = it % 384, cg = (it / 384) & 15, part = it / (384 * 16);
        const int R0 = tl * 64, sbeg = R0 < 16384 ? (R0 & ~2047) : 16384, send = R0 < 16384 ? sbeg + 2048 : 24576;
        const int t8 = lane >> 3, c8 = lane & 7, pc0 = part * 1024 + cg * 64 + c8 * 8;
        const bf16* src = proj + (size_t)(R0 + 8 * t8) * NIN + C_HY + pc0;
        v4u x[10];
#pragma unroll
        for (int i = 0; i < 8; ++i) x[1 + i] = *(const v4u*)(src + (size_t)i * NIN);
        v4u hlo = {0u, 0u, 0u, 0u}, hhi = {0u, 0u, 0u, 0u};
        if (t8 == 0 && R0 > sbeg) hlo = *(const v4u*)(src - (ptrdiff_t)NIN);
        if (t8 == 7 && R0 + 64 < send) hhi = *(const v4u*)(src + (size_t)8 * NIN);
        f32x4 w0[2], w1[2], w2[2], bb[2];
#pragma unroll
        for (int q = 0; q < 2; ++q) { w0[q] = *(const f32x4*)(cw + pc0 + 4 * q); w1[q] = *(const f32x4*)(cw + 3072 + pc0 + 4 * q); w2[q] = *(const f32x4*)(cw + 6144 + pc0 + 4 * q); bb[q] = *(const f32x4*)(cb + pc0 + 4 * q); }
        { v4u up, dn;
          up.x = __shfl(x[8].x, lane - 8); up.y = __shfl(x[8].y, lane - 8); up.z = __shfl(x[8].z, lane - 8); up.w = __shfl(x[8].w, lane - 8);
          dn.x = __shfl(x[1].x, lane + 8); dn.y = __shfl(x[1].y, lane + 8); dn.z = __shfl(x[1].z, lane + 8); dn.w = __shfl(x[1].w, lane + 8);
          x[0] = t8 == 0 ? hlo : up; x[9] = t8 == 7 ? hhi : dn; }
        float* dst = HYT + (size_t)pc0 * MTOK + R0 + 8 * t8;
#pragma unroll
        for (int k = 0; k < 8; ++k) {
            const float a0 = w0[k >> 2][k & 3], a1 = w1[k >> 2][k & 3], a2 = w2[k >> 2][k & 3], ab = bb[k >> 2][k & 3];
            float v[10];
#pragma unroll
            for (int i = 0; i < 10; ++i) { const unsigned d = (k >> 1) == 0 ? x[i].x : (k >> 1) == 1 ? x[i].y : (k >> 1) == 2 ? x[i].z : x[i].w; v[i] = (k & 1) ? bfhi(d) : bflo(d); }
            f32x4 o0, o1;
#pragma unroll
            for (int i = 0; i < 4; ++i) { o0[i] = a0 * v[i] + a1 * v[i + 1] + a2 * v[i + 2] + ab; o1[i] = a0 * v[i + 4] + a1 * v[i + 5] + a2 * v[i + 6] + ab; }
            *(f32x4*)(dst + (size_t)k * MTOK) = o0; *(f32x4*)(dst + (size_t)k * MTOK + 4) = o1;
        }
    }
}
__device__ __forceinline__ void hyena_norm(const float* ZT, const float* gain, bf16* mixed, LAS unsigned char* lds, int vb, int nb, int wave, int lane) {
    LAS float* tile = (LAS float*)(lds + wave * 16640);
    LAS float* ssx = (LAS float*)(lds + 8 * 16640);
    for (int tl = vb; tl < 384; tl += nb) {
        const int R0 = tl * 64;
        const float* src = ZT + (size_t)(wave * 128) * MTOK + R0 + lane;
        float ss = 0.f;
        for (int c = 0; c < 128; ++c) { const float v = src[(size_t)c * MTOK]; ss += v * v; }
        ssx[wave * 64 + lane] = ss;
        __syncthreads();
        float tot = 0.f;
#pragma unroll
        for (int w = 0; w < 8; ++w) tot += ssx[w * 64 + lane];
        const float rstd = 1.0f / sqrtf(tot * (1.0f / 1024.0f) + 1e-6f);
        for (int cb = 0; cb < 2; ++cb) {
            const int c0 = wave * 128 + cb * 64;
            for (int cc = 0; cc < 64; ++cc) tile[cc * 65 + lane] = src[(size_t)(cb * 64 + cc) * MTOK] * rstd;
            LDS_WAIT();
            const float gv = gain[c0 + lane];
            for (int i = 0; i < 64; ++i) mixed[(size_t)(R0 + i) * DM + 1024 + c0 + lane] = (bf16)f2bf(tile[lane * 65 + i] * gv);
            LDS_WAIT();
        }
        __syncthreads();
    }
}

__device__ __forceinline__ int trw_off(int row, int c8  , int GP) { return (row >> 2) * GP + (((c8 >> 1) * 4 + (row & 3)) * 32) + (c8 & 1) * 16; }
__device__ __forceinline__ void attn_phase(const bf16* proj, bf16* mixed, const float* rpb, const float* gain_a, LAS unsigned char* lds, int vb, int nb, int wave, int lane_in) {
    const int h = wave;
    LAS unsigned char* vt = lds + wave * 9216;
    LAS float* bt = (LAS float*)(lds + 73728 + wave * 1888);
    LAS float* ssx = (LAS float*)(lds + 73728 + 8 * 1888);
    for (int i = lane_in; i < 465; i += 64) bt[i] = rpb[h * 465 + i];
    LDS_WAIT();
    const bool wdeal = (nb == 256);
    const int u_first = wdeal ? (vb < 128 ? vb * 4 : 512 + (vb - 128) * 8) : vb, u_step = wdeal ? 1 : nb, u_end = wdeal ? u_first + (vb < 128 ? 4 : 8) : 1536;
    for (int unit = u_first; unit < u_end; unit += u_step) {
        int lane = lane_in; asm volatile("" : "+v"(lane));
        const int g = lane >> 4, qi = lane & 15;
        int r, cb, R, base;
        if (unit < 1024) { base = (unit >> 7) * 2048; r = (unit >> 2) & 31; cb = unit & 3; R = 32; } else { const int u2 = unit - 1024; base = 16384; r = u2 >> 2; cb = u2 & 3; R = 128; }
        const int row_start = min(max(r - 4, 0), R - 8), blk_start = min(max(16 * cb - 8, 0), 32);
        const int qtok = base + 64 * r + 16 * cb + qi;
        bf16x8 qf[4];
#pragma unroll
        for (int ks = 0; ks < 4; ++ks) qf[ks] = *(const bf16x8*)(proj + (size_t)qtok * NIN + C_AQ + h * 128 + ks * 32 + g * 8);
        f32x4 sc[16];
#pragma unroll
        for (int tq = 0; tq < 2; ++tq) {
            bf16x8 kf[8][4];
#pragma unroll
            for (int tt = 0; tt < 8; ++tt) { const int t = 8 * tq + tt;
                const int ktok = base + 64 * (row_start + (t >> 1)) + blk_start + 16 * (t & 1) + qi;
                const bf16* kp = proj + (size_t)ktok * NIN + C_AK + h * 128 + g * 8;
#pragma unroll
                for (int ks = 0; ks < 4; ++ks) kf[tt][ks] = *(const bf16x8*)(kp + ks * 32); }
#pragma unroll
            for (int tt = 0; tt < 8; ++tt) { f32x4 a = {0.f, 0.f, 0.f, 0.f};
#pragma unroll
                for (int ks = 0; ks < 4; ++ks) a = mfma16(kf[tt][ks], qf[ks], a);
                sc[8 * tq + tt] = a; }
        }
        const int qc = 16 * cb + qi, wst = min(max(qc - 8, 0), 48);
        float mx = -3.0e38f;
#pragma unroll
        for (int t = 0; t < 16; ++t) {
            const int dr = row_start + (t >> 1) - r + 7;
#pragma unroll
            for (int e = 0; e < 4; ++e) {
                const int kc = blk_start + 16 * (t & 1) + 4 * g + e, dc = min(max(kc - qc + 15, 0), 30);
                const bool valid = (kc >= wst) && (kc < wst + 16);
                const float v = valid ? sc[t][e] * 0.08838834764831845f + bt[dr * 31 + dc] : -1e30f;
                sc[t][e] = v; mx = fmaxf(mx, v);
            }
        }
        mx = fmaxf(mx, __shfl_xor(mx, 16)); mx = fmaxf(mx, __shfl_xor(mx, 32));
        float sum = 0.f;
#pragma unroll
        for (int t = 0; t < 16; ++t)
#pragma unroll
            for (int e = 0; e < 4; ++e) { const float p = __expf(sc[t][e] - mx); sc[t][e] = p; sum += p; }
        sum += __shfl_xor(sum, 16); sum += __shfl_xor(sum, 32);
        f32x4 o[8];
#pragma unroll
        for (int v = 0; v < 8; ++v) o[v] = (f32x4){0.f, 0.f, 0.f, 0.f};
        v4u vr[8];
        { const int vtok0 = base + 64 * row_start + blk_start;
#pragma unroll
          for (int i = 0; i < 8; ++i) { const int id = lane + 64 * i, j = id >> 4, ch = id & 15; vr[i] = *(const v4u*)(proj + (size_t)(vtok0 + j) * NIN + C_AV + h * 128 + ch * 8); } }
#pragma unroll
        for (int w = 0; w < 8; ++w) {
#pragma unroll
            for (int i = 0; i < 8; ++i) { const int id = lane + 64 * i, j = id >> 4, ch = id & 15; *(LAS v4u*)(vt + trw_off(j, ch, 1152)) = vr[i]; }
            if (w < 7) { const int vtok0 = base + 64 * (row_start + w + 1) + blk_start;
#pragma unroll
                for (int i = 0; i < 8; ++i) { const int id = lane + 64 * i, j = id >> 4, ch = id & 15; vr[i] = *(const v4u*)(proj + (size_t)(vtok0 + j) * NIN + C_AV + h * 128 + ch * 8); } }
            LDS_WAIT();
            bf16x8 pb;
            { v4u pw; pw.x = pk2(sc[2 * w][0], sc[2 * w][1]); pw.y = pk2(sc[2 * w][2], sc[2 * w][3]); pw.z = pk2(sc[2 * w + 1][0], sc[2 * w + 1][1]); pw.w = pk2(sc[2 * w + 1][2], sc[2 * w + 1][3]); pb = __builtin_bit_cast(bf16x8, pw); }
            const LAS unsigned char* tb = vt + g * 1152 + (qi >> 2) * 32 + (qi & 3) * 8;
#pragma unroll
            for (int v = 0; v < 8; ++v) {
                const s16x4 lo = tr16(tb + v * 128), hi = tr16(tb + 4 * 1152 + v * 128);
                o[v] = mfma16(cat8(lo, hi), pb, o[v]);
            }
            LDS_WAIT();
        }
        const float inv = 1.0f / sum;
        float ssq = 0.f;
#pragma unroll
        for (int v = 0; v < 8; ++v) { o[v] = o[v] * inv; ssq += (o[v].x * o[v].x + o[v].y * o[v].y) + (o[v].z * o[v].z + o[v].w * o[v].w); }
        ssq += __shfl_xor(ssq, 16); ssq += __shfl_xor(ssq, 32);
        if (g == 0) ssx[wave * 16 + qi] = ssq;
        __syncthreads();
        float tot = 0.f;
#pragma unroll
        for (int w = 0; w < 8; ++w) tot += ssx[w * 16 + qi];
        const float rs = 1.0f / sqrtf(tot * (1.0f / 1024.0f) + 1e-6f);
        __syncthreads();
#pragma unroll
        for (int v = 0; v < 8; ++v) {
            const int v0 = h * 128 + v * 16 + 4 * g;
            const f32x4 gn = *(const f32x4*)(gain_a + v0);
            v2u w; w.x = pk2(o[v].x * rs * gn.x, o[v].y * rs * gn.y); w.y = pk2(o[v].z * rs * gn.z, o[v].w * rs * gn.w);
            *(v2u*)(mixed + (size_t)qtok * DM + v0) = w;
        }
    }
}

__device__ __forceinline__ float ret_log_gamma(const float* dexp, int dir, int h) { return log1pf(-exp2f(-dexp[dir * 8 + h])); }
__device__ __forceinline__ void ret_scan(const bf16* proj, bf16* ST, bf16* FS, const float* dexp, LAS unsigned char* lds, int vb, int nb, int tid_in, int wave) {
    LAS unsigned char* Kt = lds;
    LAS unsigned char* Vt = lds + 34816;
    for (int c = vb; c < 384; c += nb) {
        int tid = tid_in; asm volatile("" : "+v"(tid));
        const int lane = tid & 63, g = lane >> 4, qi = lane & 15;
        const int vs = c >> 5, h = (c >> 2) & 7, dir = (c >> 1) & 1, dsl = c & 1;
        const bool seg = vs >= 8;
        const int base = seg ? 16384 + (vs - 8) * 2048 : vs * 2048, N = 16, nsteps = seg ? 16 : 15;
        const float lg = ret_log_gamma(dexp, dir, h), gC = expf(128.0f * lg);
        f32x4 acc[8][2];
#pragma unroll
        for (int m = 0; m < 8; ++m) { acc[m][0] = (f32x4){0.f, 0.f, 0.f, 0.f}; acc[m][1] = (f32x4){0.f, 0.f, 0.f, 0.f}; }
        v4u kr[4], vr[8];
        { const int n0 = dir == 0 ? 0 : N - 1, rowb = base + n0 * 128;
#pragma unroll
          for (int i = 0; i < 4; ++i) { const int id = tid + 512 * i, j = id >> 4, ch = id & 15; kr[i] = *(const v4u*)(proj + (size_t)(rowb + j) * NIN + C_RK + h * 256 + dsl * 128 + ch * 8); }
#pragma unroll
          for (int i = 0; i < 8; ++i) { const int id = tid + 512 * i, j = id >> 5, ch = id & 31; vr[i] = *(const v4u*)(proj + (size_t)(rowb + j) * NIN + C_RV + h * 256 + ch * 8); } }
        v2u stq[8][2]; bf16* dst_prev = nullptr;
        for (int step = 0; step <= nsteps; ++step) {
            const int n = dir == 0 ? step : N - 1 - step, tgt = dir == 0 ? n + 1 : n - 1;
            if (step < nsteps) {
                __syncthreads();
#pragma unroll
                for (int i = 0; i < 4; ++i) { const int id = tid + 512 * i, j = id >> 4, ch = id & 15;
                    v4u val = kr[i];
                    const float z = __expf(lg * (float)(dir == 0 ? 127 - j : j));
                    val.x = pk2(bflo(val.x) * z, bfhi(val.x) * z); val.y = pk2(bflo(val.y) * z, bfhi(val.y) * z); val.z = pk2(bflo(val.z) * z, bfhi(val.z) * z); val.w = pk2(bflo(val.w) * z, bfhi(val.w) * z);
                    *(LAS v4u*)(Kt + trw_off(j, ch, 1088)) = val; }
#pragma unroll
                for (int i = 0; i < 8; ++i) { const int id = tid + 512 * i, j = id >> 5, ch = id & 31; *(LAS v4u*)(Vt + trw_off(j, ch, 2112)) = vr[i]; }
                __syncthreads();
            }
            if (step > 0) {
#pragma unroll
                for (int m = 0; m < 8; ++m)
#pragma unroll
                    for (int nt = 0; nt < 2; ++nt) { const int v = (2 * wave + nt) * 16 + qi, d0 = dsl * 128 + m * 16 + 4 * g; *(v2u*)(dst_prev + v * 256 + d0) = stq[m][nt]; }
            }
            if (step == nsteps) break;
            if (step + 1 < nsteps) { const int n1 = dir == 0 ? step + 1 : N - 2 - step, rowb = base + n1 * 128;
#pragma unroll
                for (int i = 0; i < 4; ++i) { const int id = tid + 512 * i, j = id >> 4, ch = id & 15; kr[i] = *(const v4u*)(proj + (size_t)(rowb + j) * NIN + C_RK + h * 256 + dsl * 128 + ch * 8); }
#pragma unroll
                for (int i = 0; i < 8; ++i) { const int id = tid + 512 * i, j = id >> 5, ch = id & 31; vr[i] = *(const v4u*)(proj + (size_t)(rowb + j) * NIN + C_RV + h * 256 + ch * 8); } }
#pragma unroll
            for (int m = 0; m < 8; ++m) { acc[m][0] = acc[m][0] * gC; acc[m][1] = acc[m][1] * gC; }
#pragma unroll
            for (int ks = 0; ks < 4; ++ks) {
                const int rho = 8 * ks + 2 * g, lo8 = (qi >> 2) * 32 + (qi & 3) * 8;
                bf16x8 bfr[2];
#pragma unroll
                for (int nt = 0; nt < 2; ++nt) { const LAS unsigned char* p = Vt + rho * 2112 + (2 * wave + nt) * 128 + lo8; bfr[nt] = cat8(tr16(p), tr16(p + 2112)); }
#pragma unroll
                for (int m = 0; m < 8; ++m) { const LAS unsigned char* p = Kt + rho * 1088 + m * 128 + lo8; const bf16x8 af = cat8(tr16(p), tr16(p + 1088));
                    acc[m][0] = mfma16(af, bfr[0], acc[m][0]); acc[m][1] = mfma16(af, bfr[1], acc[m][1]); }
            }
            dst_prev = step < 15 ? ST + ((size_t)(((base >> 7) + tgt) * 8 + h) * 2 + dir) * 65536 : FS + ((size_t)((vs - 8) * 8 + h) * 2 + dir) * 65536;
#pragma unroll
            for (int m = 0; m < 8; ++m)
#pragma unroll
                for (int nt = 0; nt < 2; ++nt) { stq[m][nt].x = pk2(acc[m][nt].x, acc[m][nt].y); stq[m][nt].y = pk2(acc[m][nt].z, acc[m][nt].w); }
        }
        __syncthreads();
    }
}
__device__ __forceinline__ void ret_fix(bf16* ST, const bf16* FS, const float* dexp, int vb, int nb, int tid) {
    for (int it = vb; it < 64 * 8 * 2; it += nb) {
        const int dir = it & 1, h = (it >> 1) & 7, cl = it >> 4, sg = cl >> 4, nl = cl & 15;
        const int ncar = dir == 0 ? sg : 3 - sg;
        if (ncar == 0) continue;
        const bool loc = dir == 0 ? nl > 0 : nl < 15;
        const float lgd = ret_log_gamma(dexp, dir, h), c0 = __expf(lgd * 128.0f * (float)(dir == 0 ? nl : 15 - nl)), cs = __expf(lgd * 2048.0f);
        float cf[3]; cf[0] = c0; cf[1] = c0 * cs; cf[2] = c0 * cs * cs;
        bf16* dst = ST + ((size_t)((128 + cl) * 8 + h) * 2 + dir) * 65536;
#pragma unroll 4
        for (int i = 0; i < 16; ++i) { const int id = tid + 512 * i;
            v4u f[3];
#pragma unroll
            for (int k = 0; k < 3; ++k) if (k < ncar) { const int so = dir == 0 ? sg - 1 - k : sg + 1 + k; f[k] = ((const v4u*)(FS + ((size_t)(so * 8 + h) * 2 + dir) * 65536))[id]; }
            v4u l0 = {0u, 0u, 0u, 0u}; if (loc) l0 = ((const v4u*)dst)[id];
            float a[8] = {bflo(l0.x), bfhi(l0.x), bflo(l0.y), bfhi(l0.y), bflo(l0.z), bfhi(l0.z), bflo(l0.w), bfhi(l0.w)};
#pragma unroll
            for (int k = 0; k < 3; ++k) if (k < ncar) { const v4u q = f[k];
                a[0] += cf[k] * bflo(q.x); a[1] += cf[k] * bfhi(q.x); a[2] += cf[k] * bflo(q.y); a[3] += cf[k] * bfhi(q.y); a[4] += cf[k] * bflo(q.z); a[5] += cf[k] * bfhi(q.z); a[6] += cf[k] * bflo(q.w); a[7] += cf[k] * bfhi(q.w); }
            v4u r; r.x = pk2(a[0], a[1]); r.y = pk2(a[2], a[3]); r.z = pk2(a[4], a[5]); r.w = pk2(a[6], a[7]);
            ((v4u*)dst)[id] = r; }
    }
}
__device__ __forceinline__ void ret_out(const bf16* proj, const bf16* ST, bf16* mixed, const float* dexp, LAS unsigned char* lds, int vb, int nb, int tid_in0, int wave) {
    int tid_in = tid_in0; asm volatile("" : "+v"(tid_in));
    LAS unsigned char* Kt = lds;
    LAS unsigned char* Vt = lds + 67584;
    LAS unsigned char* Sx = lds;
    v4u pf[16];
    if (vb < 1536) { const int gc = vb >> 3, h = vb & 7, rowb = gc * 128;
#pragma unroll
        for (int i = 0; i < 8; ++i) { const int id = tid_in + 512 * i, j = id >> 5, ch = id & 31;
            pf[i] = *(const v4u*)(proj + (size_t)(rowb + j) * NIN + C_RK + h * 256 + ch * 8); pf[8 + i] = *(const v4u*)(proj + (size_t)(rowb + j) * NIN + C_RV + h * 256 + ch * 8); } }
    for (int unit = vb; unit < 1536; unit += nb) {
        int tid = tid_in; asm volatile("" : "+v"(tid));
        const int lane = tid & 63, g = lane >> 4, qi = lane & 15;
        const int gc = unit >> 3, h = unit & 7;
        const int n = gc < 128 ? (gc & 15) : gc - 128, N = gc < 128 ? 16 : 64;
        const int rowb = gc * 128, iq = 16 * wave + qi, qrow = rowb + iq;
        const bool have_f = n > 0, have_b = n < N - 1;
        const float lgf = ret_log_gamma(dexp, 0, h), lgb = ret_log_gamma(dexp, 1, h);
        __syncthreads();
#pragma unroll
        for (int i = 0; i < 8; ++i) { const int id = tid + 512 * i, j = id >> 5, ch = id & 31;
            *(LAS v4u*)(Kt + j * 528 + ch * 16) = pf[i]; *(LAS v4u*)(Vt + trw_off(j, ch, 2176)) = pf[8 + i]; }
        bf16x8 qf[8];
#pragma unroll
        for (int ks = 0; ks < 8; ++ks) qf[ks] = *(const bf16x8*)(proj + (size_t)qrow * NIN + C_RQ + h * 256 + ks * 32 + g * 8);
        __syncthreads();
        if (have_f) { const bf16* src = ST + ((size_t)(gc * 8 + h) * 2 + 0) * 65536;
#pragma unroll
            for (int i = 0; i < 16; ++i) { const int id = tid + 512 * i; pf[i] = *(const v4u*)(src + (id >> 5) * 256 + (id & 31) * 8); } }
        f32x4 o[16];
#pragma unroll
        for (int v = 0; v < 16; ++v) o[v] = (f32x4){0.f, 0.f, 0.f, 0.f};
#pragma unroll
        for (int k2 = 0; k2 < 4; ++k2) {
            f32x4 st[2];
#pragma unroll
            for (int jj = 0; jj < 2; ++jj) {
                const int jt = 2 * k2 + jj;
                f32x4 a = {0.f, 0.f, 0.f, 0.f};
                const LAS unsigned char* kp = Kt + (jt * 16 + qi) * 528 + g * 16;
#pragma unroll
                for (int ks = 0; ks < 8; ++ks) a = mfma16(*(const LAS bf16x8*)(kp + ks * 64), qf[ks], a);
#pragma unroll
                for (int e = 0; e < 4; ++e) { const int df = iq - (jt * 16 + 4 * g + e); a[e] *= df >= 0 ? __expf(lgf * (float)df) : __expf(lgb * (float)(-df)); }
                st[jj] = a;
            }
            bf16x8 pb;
            { v4u pw; pw.x = pk2(st[0][0], st[0][1]); pw.y = pk2(st[0][2], st[0][3]); pw.z = pk2(st[1][0], st[1][1]); pw.w = pk2(st[1][2], st[1][3]); pb = __builtin_bit_cast(bf16x8, pw); }
            const LAS unsigned char* tb = Vt + (8 * k2 + g) * 2176 + (qi >> 2) * 32 + (qi & 3) * 8;
#pragma unroll
            for (int v = 0; v < 16; ++v) { o[v] = mfma16(cat8(tr16(tb + v * 128), tr16(tb + 4 * 2176 + v * 128)), pb, o[v]); if ((v & 3) == 3) asm volatile("" ::: "memory"); }
        }
#pragma unroll
        for (int dir = 0; dir < 2; ++dir) {
            const bool have = dir == 0 ? have_f : have_b;
            __syncthreads();
            if (have) {
#pragma unroll
                for (int i = 0; i < 16; ++i) { const int id = tid + 512 * i; *(LAS v4u*)(Sx + (id >> 5) * 528 + (id & 31) * 16) = pf[i]; } }
            __syncthreads();
            if (dir == 0) { if (have_b) { const bf16* src = ST + ((size_t)(gc * 8 + h) * 2 + 1) * 65536;
#pragma unroll
                    for (int i = 0; i < 16; ++i) { const int id = tid + 512 * i; pf[i] = *(const v4u*)(src + (id >> 5) * 256 + (id & 31) * 8); } } }
            else { const int un = unit + nb;
                if (un < 1536) { const int gc2 = un >> 3, h2 = un & 7, rowb2 = gc2 * 128;
#pragma unroll
                    for (int i = 0; i < 8; ++i) { const int id = tid + 512 * i, j = id >> 5, ch = id & 31;
                        pf[i] = *(const v4u*)(proj + (size_t)(rowb2 + j) * NIN + C_RK + h2 * 256 + ch * 8); pf[8 + i] = *(const v4u*)(proj + (size_t)(rowb2 + j) * NIN + C_RV + h2 * 256 + ch * 8); } } }
            if (have) {
                const float xi = dir == 0 ? __expf(lgf * (float)(iq + 1)) : __expf(lgb * (float)(128 - iq));
#pragma unroll
                for (int kh = 0; kh < 2; ++kh) {
                    bf16x8 qs[4];
#pragma unroll
                    for (int k4 = 0; k4 < 4; ++k4) { const int ks = 4 * kh + k4; const v4u q = *(const v4u*)(proj + (size_t)qrow * NIN + C_RQ + h * 256 + ks * 32 + g * 8); v4u r;
                        r.x = pk2(bflo(q.x) * xi, bfhi(q.x) * xi); r.y = pk2(bflo(q.y) * xi, bfhi(q.y) * xi); r.z = pk2(bflo(q.z) * xi, bfhi(q.z) * xi); r.w = pk2(bflo(q.w) * xi, bfhi(q.w) * xi);
                        qs[k4] = __builtin_bit_cast(bf16x8, r); }
#pragma unroll
                    for (int v = 0; v < 16; ++v) {
                        const LAS unsigned char* sp = Sx + (v * 16 + qi) * 528 + g * 16 + kh * 256;
#pragma unroll
                        for (int k4 = 0; k4 < 4; ++k4) o[v] = mfma16(*(const LAS bf16x8*)(sp + k4 * 64), qs[k4], o[v]);
                        if ((v & 1) == 1) asm volatile("" ::: "memory");
                    }
                }
            }
        }
        float ssq = 0.f;
#pragma unroll
        for (int v = 0; v < 16; ++v) ssq += (o[v].x * o[v].x + o[v].y * o[v].y) + (o[v].z * o[v].z + o[v].w * o[v].w);
        ssq += __shfl_xor(ssq, 16); ssq += __shfl_xor(ssq, 32);
        const float rs = 1.0f / sqrtf(ssq * (1.0f / 256.0f) + 1e-6f);
#pragma unroll
        for (int v = 0; v < 16; ++v) {
            const int v0 = h * 256 + v * 16 + 4 * g;
            const v2u gw = *(const v2u*)(proj + (size_t)qrow * NIN + C_RG + v0);
            const float g0 = bflo(gw.x), g1 = bfhi(gw.x), g2 = bflo(gw.y), g3 = bfhi(gw.y);
            v2u w; w.x = pk2(o[v].x * rs * g0 / (1.0f + __expf(-g0)), o[v].y * rs * g1 / (1.0f + __expf(-g1)));
            w.y = pk2(o[v].z * rs * g2 / (1.0f + __expf(-g2)), o[v].w * rs * g3 / (1.0f + __expf(-g3)));
            *(v2u*)(mixed + (size_t)qrow * DM + 2048 + v0) = w;
            if ((v & 3) == 3) asm volatile("" ::: "memory");
        }
    }
    __syncthreads();
}

#define FFT_HD __device__ __attribute__((always_inline))
#define FFT_BREV __brev
#ifdef FFT_HOST_TEST
struct cf2 { float x, y; };
#else
typedef float cf2 __attribute__((ext_vector_type(2)));
#endif
FFT_HD inline cf2 cmulf(cf2 a, cf2 b) { cf2 r; r.x = a.x * b.x - a.y * b.y; r.y = a.x * b.y + a.y * b.x; return r; }
FFT_HD inline cf2 cmulcf(cf2 a, cf2 b) { cf2 r; r.x = a.x * b.x + a.y * b.y; r.y = a.y * b.x - a.x * b.y; return r; }
FFT_HD inline int fpad(int i) { return i + (i >> 3); }
FFT_HD inline constexpr float fc32(int k) {
    return k == 0 ? 1.0f : k == 1 ? 0.98078528040323043f : k == 2 ? 0.92387953251128674f : k == 3 ? 0.83146961230254524f : k == 4 ? 0.70710678118654752f :
           k == 5 ? 0.55557023301960218f : k == 6 ? 0.38268343236508978f : k == 7 ? 0.19509032201612825f : k == 8 ? 0.0f :
           k == 9 ? -0.19509032201612825f : k == 10 ? -0.38268343236508978f : k == 11 ? -0.55557023301960218f : k == 12 ? -0.70710678118654752f :
           k == 13 ? -0.83146961230254524f : k == 14 ? -0.92387953251128674f : k == 15 ? -0.98078528040323043f : -1.0f;
}
FFT_HD inline constexpr float fs32(int k) { return k <= 8 ? fc32(8 - k) : fc32(k - 8); }
FFT_HD inline constexpr int fbrev(int j, int bits) { int r = 0; for (int b = 0; b < bits; ++b) r |= ((j >> b) & 1) << (bits - 1 - b); return r; }

template <int R> FFT_HD inline void dft_fwd_reg(cf2 (&v)[1 << R]) {
    constexpr int n = 1 << R;
#pragma unroll
    for (int s = 0; s < R; ++s) {
        const int half = n >> (s + 1);
#pragma unroll
        for (int m = 0; m < n; ++m) {
            if ((m & half) == 0) {
                const int ml = m & (half - 1), tk = ml * (16 / half);
                const cf2 a = v[m], b = v[m + half];
                v[m].x = a.x + b.x; v[m].y = a.y + b.y;
                const cf2 d = {a.x - b.x, a.y - b.y};
                if (tk == 0) v[m + half] = d;
                else if (tk == 8) { v[m + half].x = d.y; v[m + half].y = -d.x; }
                else { const cf2 w = {fc32(tk), -fs32(tk)}; v[m + half] = cmulf(d, w); }
            }
        }
    }
}
template <int R> FFT_HD inline void dft_inv_reg(cf2 (&v)[1 << R]) {
    constexpr int n = 1 << R;
#pragma unroll
    for (int s = R - 1; s >= 0; --s) {
        const int half = n >> (s + 1);
#pragma unroll
        for (int m = 0; m < n; ++m) {
            if ((m & half) == 0) {
                const int ml = m & (half - 1), tk = ml * (16 / half);
                const cf2 a = v[m], bb = v[m + half]; cf2 b;
                if (tk == 0) b = bb;
                else if (tk == 8) { b.x = -bb.y; b.y = bb.x; }
                else { const cf2 w = {fc32(tk), -fs32(tk)}; b = cmulcf(bb, w); }
                v[m].x = a.x + b.x; v[m].y = a.y + b.y; v[m + half].x = a.x - b.x; v[m + half].y = a.y - b.y;
            }
        }
    }
}
template <int R, int F, bool CONJ> FFT_HD inline void tw_apply(cf2 (&v)[1 << R], cf2 pf, cf2 th) {
    constexpr int j = fbrev(F, R);
    v[j] = CONJ ? cmulcf(v[j], pf) : cmulf(v[j], pf);
    if constexpr (2 * F < (1 << R)) {
        const cf2 p2 = cmulf(pf, pf);
        tw_apply<R, 2 * F, CONJ>(v, p2, th);
        const cf2 p3 = cmulf(p2, th);
        tw_apply<R, 2 * F + 1, CONJ>(v, p3, th);
    }
}
template <int R, int S> FFT_HD inline int grp_base(int grp) { return (grp / S) * (S << R) + (grp & (S - 1)); }
template <int R, int S, class P> FFT_HD inline void grp_load(P X, int grp, cf2 (&v)[1 << R]) {
    P Xb = X + fpad(grp_base<R, S>(grp));
#pragma unroll
    for (int m = 0; m < (1 << R); ++m) v[m] = Xb[m * S + ((m * S) >> 3)];
}
template <int R, int S, class P> FFT_HD inline void grp_store(P X, int grp, const cf2 (&v)[1 << R]) {
    P Xb = X + fpad(grp_base<R, S>(grp));
#pragma unroll
    for (int m = 0; m < (1 << R); ++m) Xb[m * S + ((m * S) >> 3)] = v[m];
}
template <int R> FFT_HD inline void reg_fwd(cf2 (&v)[1 << R], cf2 th) { dft_fwd_reg<R>(v); tw_apply<R, 1, false>(v, th, th); }
template <int R> FFT_HD inline void reg_inv(cf2 (&v)[1 << R], cf2 th) { tw_apply<R, 1, true>(v, th, th); dft_inv_reg<R>(v); }
template <int R, class P> FFT_HD inline void lds_ld(P X, int grp, int logS, cf2 (&v)[1 << R]) {
    const int base = ((grp >> logS) << (logS + R)) + (grp & ((1 << logS) - 1));
    P Xb = X + fpad(base);
#pragma unroll
    for (int m = 0; m < (1 << R); ++m) { const int o = m << logS; v[m] = Xb[o + (o >> 3)]; }
}
template <int R, class P> FFT_HD inline void lds_st(P X, int grp, int logS, const cf2 (&v)[1 << R]) {
    const int base = ((grp >> logS) << (logS + R)) + (grp & ((1 << logS) - 1));
    P Xb = X + fpad(base);
#pragma unroll
    for (int m = 0; m < (1 << R); ++m) { const int o = m << logS; Xb[o + (o >> 3)] = v[m]; }
}
template <class LP> FFT_HD inline void p_step(int step, int t, int fi, LP X, LP Kb0t, LP Kb1t, const cf2* TW, float* hv, const float* hx1, const float* hx2, const float* f0, const float* f1) {
    if (step == 3) {
        const float s = 0.5f / 4096.0f;
#pragma unroll 4
        for (int m = 0; m < 16; ++m) { const int p = 16 * t + m, f = (int)(FFT_BREV((unsigned)p) >> 20), p2 = (int)(FFT_BREV((unsigned)((4096 - f) & 4095)) >> 20);
            const cf2 z = X[fpad(p)], w = X[fpad(p2)]; cf2 k;
            if (fi == 0) { k.x = s * (z.x + w.x); k.y = s * (z.y - w.y); Kb0t[256 * m] = k; } else { k.x = s * (z.y + w.y); k.y = s * (w.x - z.x); Kb1t[256 * m] = k; } }
        return;
    }
    int pos, r = 0;
    bool filt = step < 3;
    if (filt) pos = step; else { r = (step - 4) / 9; pos = (step - 4) - 9 * r; }
    const int pp = pos >= 5 && pos <= 7 ? pos - 4 : pos;
    const int pr = 2 * r + fi;
    const int logS = (pp == 0 || pp == 4 || pp == 8) ? 8 : (pp == 2 ? 0 : 4);
    const bool do_inv = (pp == 3 || pp == 4 || pp == 8), do_fwd = (pp == 0 || pp == 1 || pp == 2 || pp == 4), do_k = (pp == 2 && !filt);
    const cf2 th = (logS == 8) ? TW[t * 4] : TW[(t & 15) * 64];
    cf2 v[16];
    if (pp == 0) {
        if (filt) {
#pragma unroll
            for (int m = 0; m < 16; ++m) { v[m].x = f0[t + 256 * m]; v[m].y = f1[t + 256 * m]; }
        } else { const float* a = hv + pr * 4096 + t;
#pragma unroll
            for (int m = 0; m < 16; ++m) { v[m].x = m < 8 ? a[256 * m] : 0.f; v[m].y = m < 8 ? a[2048 + 256 * m] : 0.f; } }
    } else lds_ld<4>(X, t, logS, v);
    float ga[8], gb[8];
    if (pp == 4 || pp == 8) { const float* g = (pos == 4 ? hx1 : hx2) + pr * 4096 + t;
#pragma unroll
        for (int m = 0; m < 8; ++m) { ga[m] = g[256 * m]; gb[m] = g[2048 + 256 * m]; } }
    if (do_inv) { if (logS != 0) tw_apply<4, 1, true>(v, th, th); dft_inv_reg<4>(v); }
    if (pp == 4) {
#pragma unroll
        for (int m = 0; m < 16; ++m) { v[m].x = m < 8 ? v[m].x * ga[m] : 0.f; v[m].y = m < 8 ? v[m].y * gb[m] : 0.f; } }
    if (pp == 8) { float* a = hv + pr * 4096 + t;
#pragma unroll
        for (int m = 0; m < 8; ++m) { a[256 * m] = v[m].x * ga[m]; a[2048 + 256 * m] = v[m].y * gb[m]; }
        return; }
    if (do_fwd) { dft_fwd_reg<4>(v); if (logS != 0) tw_apply<4, 1, false>(v, th, th); }
    if (do_k) { LP K = (pos == 2) ? Kb0t : Kb1t;
#pragma unroll
        for (int m = 0; m < 16; ++m) v[m] = cmulf(v[m], K[256 * m]);
        dft_inv_reg<4>(v); }
    lds_st<4>(X, t, logS, v);
}
template <class LP> FFT_HD inline void s_step(int step, int t, LP X, const cf2* TW, const float* hv, const float* hx1, const float* hx2, const float* f0, const float* f1, float* outp) {
    const int s7 = step >= 7 ? step - 6 : step;
    if (s7 == 3) {
        const float sc = 0.25f / 16384.0f;
#pragma unroll 4
        for (int j = 0; j < 32; ++j) {
            const int p = t + 512 * j, f = (int)(FFT_BREV((unsigned)p) >> 18), f2 = (16384 - f) & 16383;
            if (f <= f2) { const int p2 = (int)(FFT_BREV((unsigned)f2) >> 18);
                const cf2 z = X[fpad(p)], w = X[fpad(p2)];
                const float P = z.x * z.x - z.y * z.y - w.x * w.x + w.y * w.y, Q = 2.0f * (z.x * z.y + w.x * w.y);
                cf2 a, b; a.x = Q * sc; a.y = -P * sc; b.x = Q * sc; b.y = P * sc;
                X[fpad(p)] = a; X[fpad(p2)] = b; }
        }
        return;
    }
    if (s7 == 2 || s7 == 4) {
#pragma unroll 1
        for (int q = 0; q < 2; ++q) { const int grp = t + 512 * q; cf2 v[16]; lds_ld<4>(X, grp, 0, v); if (s7 == 2) dft_fwd_reg<4>(v); else dft_inv_reg<4>(v); lds_st<4>(X, grp, 0, v); }
        return;
    }
    const bool isA = (step == 0 || step == 6 || step == 12);
    const int logS = isA ? 9 : 4;
    const bool do_inv = (step == 5 || step == 6 || step == 11 || step == 12), do_fwd = (step == 0 || step == 1 || step == 6 || step == 7);
    const cf2 th = isA ? TW[t] : TW[(t & 15) * 32];
    cf2 v[32];
    if (step == 0) {
#pragma unroll
        for (int m = 0; m < 32; ++m) { v[m].x = m < 16 ? hv[t + 512 * m] : 0.f; v[m].y = f0[t + 512 * m]; }
    } else lds_ld<5>(X, t, logS, v);
    if (do_inv) { tw_apply<5, 1, true>(v, th, th); dft_inv_reg<5>(v); }
    if (step == 6) {
#pragma unroll
        for (int m = 0; m < 32; ++m) { v[m].x = m < 16 ? v[m].x * hx1[t + 512 * m] : 0.f; v[m].y = f1[t + 512 * m]; } }
    if (step == 12) {
#pragma unroll
        for (int m = 0; m < 16; ++m) outp[t + 512 * m] = v[m].x * hx2[t + 512 * m];
        return; }
    if (do_fwd) { dft_fwd_reg<5>(v);
#if defined(DBG_FFT_EXTRA)
        dft_inv_reg<5>(v);
#pragma unroll
        for (int m = 0; m < 32; ++m) { v[m].x *= 0.03125f; v[m].y *= 0.03125f; }
        dft_fwd_reg<5>(v);
#endif
        tw_apply<5, 1, false>(v, th, th); }
    lds_st<5>(X, t, logS, v);
}
typedef LAS cf2* ldsc;
#define HC_NO_P 1
#ifndef HC_UNITS
#define HC_UNITS 1024
#endif
__device__ __forceinline__ cf2 tw_fresh(cf2 th) { asm volatile("" : "+v"(th.x), "+v"(th.y)); return th; }
__device__ __forceinline__ void s_mid2(ldsc X, const cf2* TW, int tid) {
#pragma unroll 1
    for (int q = 0; q < 2; ++q) { const int grp = tid + 512 * q; cf2 v[16]; grp_load<4, 64>(X, grp, v); reg_fwd<4>(v, TW[(grp & 63) * 16]); grp_store<4, 64>(X, grp, v); }
    __syncthreads();
#pragma unroll 1
    for (int q = 0; q < 4; ++q) { const int grp = tid + 512 * q; cf2 v[8]; grp_load<3, 8>(X, grp, v); reg_fwd<3>(v, TW[(grp & 7) * 256]); grp_store<3, 8>(X, grp, v); }
    __syncthreads();
#pragma unroll 1
    for (int q = 0; q < 4; ++q) { const int grp = tid + 512 * q; cf2 v[8]; grp_load<3, 1>(X, grp, v); dft_fwd_reg<3>(v); grp_store<3, 1>(X, grp, v); }
    __syncthreads();
    { const float sc = 0.25f / 16384.0f;
#pragma unroll 4
      for (int j = 0; j < 32; ++j) {
        const int p = tid + 512 * j, f = (int)(__brev((unsigned)p) >> 18), f2 = (16384 - f) & 16383;
        if (f <= f2) { const int p2 = (int)(__brev((unsigned)f2) >> 18);
            const cf2 z = X[fpad(p)], w = X[fpad(p2)];
            const float P = z.x * z.x - z.y * z.y - w.x * w.x + w.y * w.y, Q = 2.0f * (z.x * z.y + w.x * w.y);
            cf2 a, b; a.x = Q * sc; a.y = -P * sc; b.x = Q * sc; b.y = P * sc;
            X[fpad(p)] = a; X[fpad(p2)] = b; }
      } }
    __syncthreads();
#pragma unroll 1
    for (int q = 0; q < 4; ++q) { const int grp = tid + 512 * q; cf2 v[8]; grp_load<3, 1>(X, grp, v); dft_inv_reg<3>(v); grp_store<3, 1>(X, grp, v); }
    __syncthreads();
#pragma unroll 1
    for (int q = 0; q < 4; ++q) { const int grp = tid + 512 * q; cf2 v[8]; grp_load<3, 8>(X, grp, v); reg_inv<3>(v, TW[(grp & 7) * 256]); grp_store<3, 8>(X, grp, v); }
    __syncthreads();
#pragma unroll 1
    for (int q = 0; q < 2; ++q) { const int grp = tid + 512 * q; cf2 v[16]; grp_load<4, 64>(X, grp, v); reg_inv<4>(v, TW[(grp & 63) * 16]); grp_store<4, 64>(X, grp, v); }
    __syncthreads();
}
__device__ __forceinline__ void hyena_conv_s2(const float* HYT, float* ZOUT, const float* FILT, const cf2* TW, LAS unsigned char* lds, int vb, int nb, int tid_in) {
    ldsc X = (ldsc)lds;
    for (int u = vb; u < 1024; u += nb) {
        int tid = tid_in; asm volatile("" : "+v"(tid));
        __syncthreads();
        const int c = u;
        const float* hv = HYT + (size_t)c * MTOK + 16384; const float* hx1 = HYT + (size_t)(1024 + c) * MTOK + 16384; const float* hx2 = HYT + (size_t)(2048 + c) * MTOK + 16384;
        float* zo = ZOUT + (size_t)c * MTOK + 16384;
        const float* f0 = FILT + FILT_L1_OFF + (size_t)c * 16384; const float* f1 = FILT + FILT_L1_OFF + (size_t)(1024 + c) * 16384;
#pragma unroll 1
        for (int q = 0; q < 2; ++q) { const int grp = tid + 512 * q; cf2 v[16];
#pragma unroll
            for (int m = 0; m < 16; ++m) { v[m].x = m < 8 ? hv[grp + 1024 * m] : 0.f; v[m].y = f0[grp + 1024 * m]; }
            reg_fwd<4>(v, TW[grp]); grp_store<4, 1024>(X, grp, v); }
        __syncthreads();
        s_mid2(X, TW, tid);
#pragma unroll 1
        for (int q = 0; q < 2; ++q) { const int grp = tid + 512 * q; cf2 v[16]; float g1[8], fl[16];
#pragma unroll
            for (int m = 0; m < 16; ++m) { if (m < 8) g1[m] = hx1[grp + 1024 * m]; fl[m] = f1[grp + 1024 * m]; }
            const cf2 th = TW[grp];
            grp_load<4, 1024>(X, grp, v); reg_inv<4>(v, th);
#pragma unroll
            for (int m = 0; m < 16; ++m) { v[m].x = m < 8 ? v[m].x * g1[m] : 0.f; v[m].y = fl[m]; }
            reg_fwd<4>(v, tw_fresh(th)); grp_store<4, 1024>(X, grp, v); }
        __syncthreads();
        s_mid2(X, TW, tid);
#pragma unroll 1
        for (int q = 0; q < 2; ++q) { const int grp = tid + 512 * q; cf2 v[16]; float g2[8];
#pragma unroll
            for (int m = 0; m < 8; ++m) g2[m] = hx2[grp + 1024 * m];
            grp_load<4, 1024>(X, grp, v); reg_inv<4>(v, TW[grp]);
#pragma unroll
            for (int m = 0; m < 8; ++m) zo[grp + 1024 * m] = v[m].x * g2[m]; }
    }
    __syncthreads();
}
__device__ __forceinline__ void hyena_conv(const float* HYT, float* ZOUT, const float* FILT, const cf2* TW, LAS unsigned char* lds, int vb, int nb, int tid_in) {
    for (int u = vb; u < HC_UNITS; u += nb) {
        int tid = tid_in; asm volatile("" : "+v"(tid));
        __syncthreads();
#ifndef HC_NO_S
        if (u < 1024) {
            const int c = u;
            const float* hv = HYT + (size_t)c * MTOK + 16384; float* zo = ZOUT + (size_t)c * MTOK + 16384; const float* hx1 = HYT + (size_t)(1024 + c) * MTOK + 16384; const float* hx2 = HYT + (size_t)(2048 + c) * MTOK + 16384;
            const float* f0 = FILT + FILT_L1_OFF + (size_t)c * 16384; const float* f1 = FILT + FILT_L1_OFF + (size_t)(1024 + c) * 16384;
#pragma unroll 1
            for (int step = 0; step < 13; ++step) { int st = step, tt = tid; asm volatile("" : "+s"(st), "+v"(tt)); s_step(st, tt, (ldsc)lds, TW, hv, hx1, hx2, f0, f1, zo); __syncthreads(); }
        }
#endif
#ifndef HC_NO_P
        if (u >= 1024) {
            const int c = u - 1024, fi = tid >> 8, t = tid & 255;
            float* hv = HYT + (size_t)c * MTOK; const float* hx1 = HYT + (size_t)(1024 + c) * MTOK; const float* hx2 = HYT + (size_t)(2048 + c) * MTOK;
            const float* f0 = FILT + (size_t)c * 4096; const float* f1 = FILT + (size_t)(1024 + c) * 4096;
            ldsc X = (ldsc)(lds + fi * 36864);
#pragma unroll 1
            for (int step = 0; step < 22; ++step) { int st = step, tt = t; asm volatile("" : "+s"(st), "+v"(tt)); p_step(st, tt, fi, X, (ldsc)(lds + 73728) + tt, (ldsc)(lds + 73728 + 32768) + tt, TW, hv, hx1, hx2, f0, f1); __syncthreads(); }
        }
#endif
    }
    __syncthreads();
}

#define FFT_LDSU LAS unsigned
#define FFT_SINCOSPI sincospif
typedef _Float16 hf16;
typedef hf16 h8v __attribute__((ext_vector_type(8)));
typedef hf16 h2v __attribute__((ext_vector_type(2)));
struct cplx { float x, y; };
constexpr int FM_PITCH = 272;
constexpr int FM_BUF = 64 * FM_PITCH;
FFT_HD inline unsigned fm_pack(float re, float im) { h2v h; h.x = (hf16)re; h.y = (hf16)im; return __builtin_bit_cast(unsigned, h); }
FFT_HD inline float fm_fblk(int w, int ks, int lane, int j) {
    const int x = lane & 15, g = lane >> 4, k1 = 8 * w + (x >> 1), part = x & 1, r = 16 * ks + 4 * g + (j >> 1), pp = j & 1;
    float sn, cs; FFT_SINCOSPI(2.0f * (float)((k1 * r) & 63) / 64.0f, &sn, &cs);
    return part == 0 ? (pp == 0 ? cs : sn) : (pp == 0 ? -sn : cs);
}
FFT_HD inline cplx fm_tw(int w, int lane, int nt, int q) {
    const int k1 = 8 * w + 2 * (lane >> 4) + q, c = 16 * nt + (lane & 15);
    float sn, cs; FFT_SINCOSPI(-2.0f * (float)((k1 * c) & 4095) / 4096.0f, &sn, &cs); cplx t; t.x = cs; t.y = sn; return t;
}
FFT_HD inline int fm_boff(int lane, int nt, int ks) { return (16 * nt + (lane & 15)) * FM_PITCH + (16 * ks + 4 * (lane >> 4)) * 4; }
template <class BP> FFT_HD inline void fm_e1(BP dst, int w, int lane, int nt, const float (&a)[4], const cplx (&tw)[2]) {
    const int g = lane >> 4, c = 16 * nt + (lane & 15);
#pragma unroll
    for (int q = 0; q < 2; ++q) { const float yr = a[2 * q], yi = a[2 * q + 1]; const int k1 = 8 * w + 2 * g + q;
        *(FFT_LDSU*)(dst + k1 * FM_PITCH + c * 4) = fm_pack(yr * tw[q].x - yi * tw[q].y, yr * tw[q].y + yi * tw[q].x); }
}
template <class BP> FFT_HD inline void fm_e2(BP dst, int w, int lane, int nt, const float (&a)[4], const cplx (&K)[2]) {
    const int g = lane >> 4, k1 = 16 * nt + (lane & 15), k2 = 8 * w + 2 * g;
    unsigned o[2];
#pragma unroll
    for (int q = 0; q < 2; ++q) { const float xr = a[2 * q], xi = a[2 * q + 1]; o[q] = fm_pack(xr * K[q].x - xi * K[q].y, -(xr * K[q].y + xi * K[q].x)); }
    FFT_LDSU* p = (FFT_LDSU*)(dst + k1 * FM_PITCH + k2 * 4); p[0] = o[0]; p[1] = o[1];
}
template <class BP> FFT_HD inline void fm_e3(BP dst, int w, int lane, int nt, const float (&a)[4], const float* ga, const float* gb) {
    const int g = lane >> 4, k1 = 16 * nt + (lane & 15), k2 = 8 * w + 2 * g;
    unsigned o[2] = {0u, 0u};
    if (w < 4) {
#pragma unroll
        for (int q = 0; q < 2; ++q) { const int t = k1 + 64 * (k2 + q); o[q] = fm_pack(a[2 * q] * ga[t], -a[2 * q + 1] * gb[t]); } }
    FFT_LDSU* p = (FFT_LDSU*)(dst + k1 * FM_PITCH + k2 * 4); p[0] = o[0]; p[1] = o[1];
}
FFT_HD inline void fm_e4(float* oa, float* ob, int w, int lane, int nt, const float (&a)[4], const float* ga, const float* gb) {
    if (w < 4) { const int g = lane >> 4, k1 = 16 * nt + (lane & 15), k2 = 8 * w + 2 * g;
#pragma unroll
        for (int q = 0; q < 2; ++q) { const int t = k1 + 64 * (k2 + q); oa[t] = a[2 * q] * ga[t]; ob[t] = -a[2 * q + 1] * gb[t]; } }
}
template <class FP> FFT_HD inline void fm_e2f(FP nmf, int w, int lane, int nt, const float (&a)[4]) {
    const int g = lane >> 4, k1 = 16 * nt + (lane & 15), k2 = 8 * w + 2 * g;
#pragma unroll
    for (int q = 0; q < 2; ++q) { const int f = k1 + 64 * (k2 + q); nmf[2 * f] = a[2 * q]; nmf[2 * f + 1] = a[2 * q + 1]; }
}
template <class FP> FFT_HD inline void fm_split(FP nmf, int w, int lane, int nt, cplx (&K0)[2], cplx (&K1)[2]) {
    const int g = lane >> 4, k1 = 16 * nt + (lane & 15), k2 = 8 * w + 2 * g; const float s = 0.5f / 4096.0f;
#pragma unroll
    for (int q = 0; q < 2; ++q) { const int f = k1 + 64 * (k2 + q), f2 = (4096 - f) & 4095;
        const float zr = nmf[2 * f], zi = nmf[2 * f + 1], wr = nmf[2 * f2], wi = nmf[2 * f2 + 1];
        K0[q].x = s * (zr + wr); K0[q].y = s * (zi - wi); K1[q].x = s * (zi + wi); K1[q].y = s * (wr - zr); }
}
template <class BP> FFT_HD inline void fm_load(BP dst, int tid, const float* a, const float* b, bool full) {
#pragma unroll
    for (int i = 0; i < 4; ++i) { const int t = tid + 512 * i;
        *(FFT_LDSU*)(dst + (t & 63) * FM_PITCH + (t >> 6) * 4) = fm_pack(a[t], b[t]);
        const int t2 = t + 2048;
        *(FFT_LDSU*)(dst + (t2 & 63) * FM_PITCH + (t2 >> 6) * 4) = full ? fm_pack(a[t2], b[t2]) : 0u; }
}
template <class BP> FFT_HD inline void fm_e3v(BP dst, int w, int lane, int nt, const float (&a)[4], const float (&ga)[2], const float (&gb)[2]) {
    const int g = lane >> 4, k1 = 16 * nt + (lane & 15), k2 = 8 * w + 2 * g;
    unsigned o[2] = {0u, 0u};
    if (w < 4) { o[0] = fm_pack(a[0] * ga[0], -a[1] * gb[0]); o[1] = fm_pack(a[2] * ga[1], -a[3] * gb[1]); }
    FFT_LDSU* p = (FFT_LDSU*)(dst + k1 * FM_PITCH + k2 * 4); p[0] = o[0]; p[1] = o[1];
}
FFT_HD inline unsigned fm_tidx(int w, int lane, int nt, int q) { return (unsigned)(16 * nt + (lane & 15) + 64 * (8 * w + 2 * (lane >> 4) + q)); }
typedef LAS unsigned char* ldsb;
struct FmConst { h8v afr[4]; cplx tw[4][2]; };
__device__ __forceinline__ void fm_matmul(ldsb buf, int lane, const FmConst& C, f32x4 (&acc)[4]) {
#pragma unroll
    for (int nt = 0; nt < 4; ++nt) acc[nt] = (f32x4){0.f, 0.f, 0.f, 0.f};
#pragma unroll
    for (int ks = 0; ks < 4; ++ks)
#pragma unroll
        for (int nt = 0; nt < 4; ++nt) acc[nt] = __builtin_amdgcn_mfma_f32_16x16x32_f16(C.afr[ks], *(const LAS h8v*)(buf + fm_boff(lane, nt, ks)), acc[nt], 0, 0, 0);
}
__device__ __forceinline__ void fm_sweep(ldsb lds, int& cur, int w, int lane, const FmConst& C, f32x4 (&acc)[4]) {
    fm_matmul(lds + cur * FM_BUF, lane, C, acc);
#pragma unroll
    for (int nt = 0; nt < 4; ++nt) { const float a[4] = {acc[nt].x, acc[nt].y, acc[nt].z, acc[nt].w}; fm_e1(lds + (cur ^ 1) * FM_BUF, w, lane, nt, a, C.tw[nt]); }
    __syncthreads(); cur ^= 1;
    fm_matmul(lds + cur * FM_BUF, lane, C, acc);
}
__device__ __forceinline__ void hyena_conv_p(const float* HYT, float* ZOUT, const float* FILT, const unsigned char* fmtab, LAS unsigned char* lds, int vb, int nb, int tid_in) {
    FmConst C;
    { int tid = tid_in; asm volatile("" : "+v"(tid));
#pragma unroll
      for (int ks = 0; ks < 4; ++ks) C.afr[ks] = ((const h8v*)fmtab)[tid * 4 + ks];
#pragma unroll
      for (int nt = 0; nt < 4; ++nt) { C.tw[nt][0] = ((const cplx*)(fmtab + 32768))[tid * 8 + 2 * nt]; C.tw[nt][1] = ((const cplx*)(fmtab + 32768))[tid * 8 + 2 * nt + 1]; } }
    LAS float* nmf = (LAS float*)(lds + 2 * FM_BUF);
    for (int u = vb; u < 1024; u += nb) {
        int tid = tid_in; asm volatile("" : "+v"(tid));
        const int lane = tid & 63, w = __builtin_amdgcn_readfirstlane(tid >> 6);
        const int c = u;
        const float* hv = HYT + (size_t)c * MTOK; float* zo = ZOUT + (size_t)c * MTOK; const float* hx1 = HYT + (size_t)(1024 + c) * MTOK; const float* hx2 = HYT + (size_t)(2048 + c) * MTOK;
        const float* f0 = FILT + (size_t)c * 4096; const float* f1 = FILT + (size_t)(1024 + c) * 4096;
        int cur = 0; f32x4 acc[4];
        cplx K0[4][2], K1[4][2];
        __syncthreads();
        fm_load(lds, tid, f0, f1, true);
        __syncthreads();
        fm_sweep(lds, cur, w, lane, C, acc);
#pragma unroll
        for (int nt = 0; nt < 4; ++nt) { const float a[4] = {acc[nt].x, acc[nt].y, acc[nt].z, acc[nt].w}; fm_e2f(nmf, w, lane, nt, a); }
        __syncthreads(); cur ^= 1;
#pragma unroll
        for (int nt = 0; nt < 4; ++nt) fm_split(nmf, w, lane, nt, K0[nt], K1[nt]);
#pragma unroll 1
        for (int pr = 0; pr < 4; ++pr) {
            const float* va = hv + pr * 4096; const float* x1a = hx1 + pr * 4096; const float* x2a = hx2 + pr * 4096; float* oa = zo + pr * 4096;
            __syncthreads();
            fm_load(lds + cur * FM_BUF, tid, va, va + 2048, false);
            float ga[4][2], gb[4][2];
            if (w < 4) {
#pragma unroll
                for (int nt = 0; nt < 4; ++nt)
#pragma unroll
                    for (int q = 0; q < 2; ++q) { const unsigned t = fm_tidx(w, lane, nt, q); ga[nt][q] = x1a[t]; gb[nt][q] = x1a[2048u + t]; } }
            __syncthreads();
            fm_sweep(lds, cur, w, lane, C, acc);
#pragma unroll
            for (int nt = 0; nt < 4; ++nt) { const float a[4] = {acc[nt].x, acc[nt].y, acc[nt].z, acc[nt].w}; fm_e2(lds + (cur ^ 1) * FM_BUF, w, lane, nt, a, K0[nt]); }
            __syncthreads(); cur ^= 1;
            fm_sweep(lds, cur, w, lane, C, acc);
#pragma unroll
            for (int nt = 0; nt < 4; ++nt) { const float a[4] = {acc[nt].x, acc[nt].y, acc[nt].z, acc[nt].w}; fm_e3v(lds + (cur ^ 1) * FM_BUF, w, lane, nt, a, ga[nt], gb[nt]); }
            if (w < 4) {
#pragma unroll
                for (int nt = 0; nt < 4; ++nt)
#pragma unroll
                    for (int q = 0; q < 2; ++q) { const unsigned t = fm_tidx(w, lane, nt, q); ga[nt][q] = x2a[t]; gb[nt][q] = x2a[2048u + t]; } }
            __syncthreads(); cur ^= 1;
            fm_sweep(lds, cur, w, lane, C, acc);
#pragma unroll
            for (int nt = 0; nt < 4; ++nt) { const float a[4] = {acc[nt].x, acc[nt].y, acc[nt].z, acc[nt].w}; fm_e2(lds + (cur ^ 1) * FM_BUF, w, lane, nt, a, K1[nt]); }
            __syncthreads(); cur ^= 1;
            fm_sweep(lds, cur, w, lane, C, acc);
            if (w < 4) {
#pragma unroll
                for (int nt = 0; nt < 4; ++nt)
#pragma unroll
                    for (int q = 0; q < 2; ++q) { const unsigned t = fm_tidx(w, lane, nt, q); const float yr = q ? acc[nt].z : acc[nt].x, yi = q ? acc[nt].w : acc[nt].y; oa[t] = yr * ga[nt][q]; oa[2048u + t] = -yi * gb[nt][q]; } }
            cur ^= 1;
        }
    }
    __syncthreads();
}

__device__ __forceinline__ void fm_tables(unsigned char* fmtab, int tid) {
    const int lane = tid & 63, w = tid >> 6;
#pragma unroll
    for (int ks = 0; ks < 4; ++ks) { h8v a;
#pragma unroll
        for (int j = 0; j < 8; ++j) a[j] = (hf16)fm_fblk(w, ks, lane, j);
        ((h8v*)fmtab)[tid * 4 + ks] = a; }
#pragma unroll
    for (int nt = 0; nt < 4; ++nt) { ((cplx*)(fmtab + 32768))[tid * 8 + 2 * nt] = fm_tw(w, lane, nt, 0); ((cplx*)(fmtab + 32768))[tid * 8 + 2 * nt + 1] = fm_tw(w, lane, nt, 1); }
}

#ifndef PMASK
#define PMASK 0xFFFF
#endif
#define PM(b) ((PMASK >> (b)) & 1)
#ifndef DBG_DOUBLE
#define DBG_DOUBLE 0
#endif
struct Args { const float* in[26]; float* out; unsigned char* ws; int ph_lo, ph_hi, li, pad; };
typedef const __attribute__((address_space(4))) unsigned char* kaptr;
__device__ __forceinline__ kaptr ka_fresh() { kaptr p = (kaptr)__builtin_amdgcn_kernarg_segment_ptr(); asm volatile("" : "+s"(p)); return p; }
#define KA_IN(ka, i) (*(const float* const __attribute__((address_space(4)))*)((ka) + 8 * (i)))
#define KA_OUT(ka) (*(float* const __attribute__((address_space(4)))*)((ka) + 208))
#define KA_WS(ka) (*(unsigned char* const __attribute__((address_space(4)))*)((ka) + 216))
#define KA_INT(ka, off) (*(const int __attribute__((address_space(4)))*)((ka) + (off)))
__global__ void __launch_bounds__(NT, 2) fwd_kernel(Args args_unused) {
    extern __shared__ __attribute__((aligned(16))) unsigned char lds_raw[];
    LAS unsigned char* lds = (LAS unsigned char*)lds_raw;
    volatile LAS unsigned* MISC = (volatile LAS unsigned*)(lds + MISC_OFF);
    const int tid0 = threadIdx.x;
#define PHASE_IDS() int vcu = vcu0, G = G0; asm volatile("" : "+s"(vcu), "+s"(G)); const int ngw = G * NWAVES; (void)ngw; int tid = tid0; asm volatile("" : "+v"(tid)); const int lane = tid & 63, wave = __builtin_amdgcn_readfirstlane(tid >> 6), gw = vcu * NWAVES + wave; (void)lane; (void)gw
    const int G0 = gridDim.x, bx = blockIdx.x, vcu0 = (G0 % 8 == 0) ? (bx % 8) * (G0 / 8) + bx / 8 : bx;
    for (int u = tid0; u < (LDS_BYTES - MISC_OFF) / 4; u += NT) ((LAS unsigned*)(lds + MISC_OFF))[u] = 0u;
    __syncthreads();
    int lo, hi;
    XcdBarrier bar;
    { kaptr ka = ka_fresh(); lo = KA_INT(ka, 224); hi = KA_INT(ka, 228); unsigned* ctl = (unsigned*)(KA_WS(ka) + WS_CTL) + CW_BAR + KA_INT(ka, 232) * XCD_BAR_WORDS;
      bar.bar = ctl; bar.x = 0; bar.st = MISC + 8;
      if (hi - lo > 1) bar = xcd_barrier_post(ctl, MISC + 8); }
#define IN(k) (lo <= (k) && (k) < hi)
#define SEAM(k) do { if (IN(k) && IN((k) + 1)) { XcdBarrier b2 = bar; asm volatile("" : "+s"(b2.x)); xcd_barrier(b2); } } while (0)
#define WSP(T, off) ((T*)(ws + (off)))

    if (IN(0)) {
        PHASE_IDS(); kaptr ka = ka_fresh(); unsigned char* ws = KA_WS(ka); float* xres = KA_OUT(ka);
        if (PM(0)) for (int m = gw; m < MTOK; m += ngw) { const float* src = m < 16384 ? KA_IN(ka, 0) + (size_t)m * DM : KA_IN(ka, 1) + (size_t)(m - 16384) * DM;
            ln_row_in(src, KA_IN(ka, 2), KA_IN(ka, 3), WSP(bf16, WS_XB) + (size_t)m * DM, WSP(signed char, WS_XQ) + (size_t)m * DM, WSP(float, WS_ROWINV3) + m, lane); }
        for (int l2 = 0; l2 < 2; ++l2) { const float* wl = KA_IN(ka, 4) + (size_t)l2 * DM * NIN; unsigned* cm = WSP(unsigned, WS_CTL) + CW_CMAX + l2 * NIN;
            colmax_f32(wl + C_AV, DM, NIN, 2048, cm + C_AV, gw, ngw, lane); colmax_f32(wl + C_RQ, DM, NIN, 8192, cm + C_RQ, gw, ngw, lane); }
        if (vcu == 0) fm_tables(WSP(unsigned char, WS_FMTAB), tid);
        if (PM(1)) pre_tables(KA_IN(ka, 8), KA_IN(ka, 9), KA_IN(ka, 10), KA_IN(ka, 11), KA_IN(ka, 12), ws, gw, ngw, lane);
        { unsigned* ctl = WSP(unsigned, WS_CTL); const size_t n4 = (size_t)DM * NFF2 / 4;
          absmax_f32(KA_IN(ka, 22), n4, ctl + CW_WMAX, (size_t)gw * 64 + lane, (size_t)ngw * 64, lane);
          absmax_f32(KA_IN(ka, 22) + (size_t)DM * NFF2, n4, ctl + CW_WMAX + 1, (size_t)gw * 64 + lane, (size_t)ngw * 64, lane);
          const size_t m4 = (size_t)DFF * DM / 4;
          absmax_f32(KA_IN(ka, 23), m4, ctl + CW_WMAX + 2, (size_t)gw * 64 + lane, (size_t)ngw * 64, lane);
          absmax_f32(KA_IN(ka, 23) + (size_t)DFF * DM, m4, ctl + CW_WMAX + 3, (size_t)gw * 64 + lane, (size_t)ngw * 64, lane); }
    }
    SEAM(0);
    if (IN(1)) {
        PHASE_IDS(); kaptr ka = ka_fresh(); unsigned char* ws = KA_WS(ka);
        for (int rep = 0; rep < 1 + ((DBG_DOUBLE >> 2) & 1); ++rep) if (PM(2)) convert_weights(KA_IN(ka, 4), KA_IN(ka, 19), KA_IN(ka, 22), KA_IN(ka, 23), ws, WSP(const unsigned, WS_CTL) + CW_WMAX, WSP(const unsigned, WS_CTL) + CW_CMAX, lds, gw, ngw, wave, lane);
    }
    SEAM(1);
    for (int l = 0; l < 2; ++l) {
        const int P = 2 + l * NPH;
        if (IN(P + 0)) {
            PHASE_IDS(); kaptr ka = ka_fresh(); unsigned char* ws = KA_WS(ka);
            { pg8::Gemm g{WSP(bf16, WS_XB), WSP(const bf16, WS_WIN), MTOK, NB16, DM}; pg8::StaticOrder S; S.init(MTOK, NB16, G, bx);
              pg8::EpiProj E{WSP(bf16, WS_PROJ), WSP(const float, WS_ROPE)};
              if (PM(3)) pg8::gemm_phase<pg8::EpiProj, pg8::StaticOrder, true, true, false, true>(lds, g, S, E); }
            { pg8::Gemm g{WSP(bf16, WS_XQ), WSP(const bf16, WS_WINQ), MTOK, NQN, DM}; pg8::StaticOrder S; S.init(MTOK, NQN, G, bx);
              pg8::EpiProjV E{WSP(bf16, WS_PROJ), WSP(const float, WS_ROPE), WSP(const float, WS_ROWINV3), WSP(const float, WS_CTL) + CW_CMAX + l * NIN};
              if (PM(3)) pg8::gemm_phase<pg8::EpiProjV, pg8::StaticOrder, true, true, true>(lds, g, S, E); }
        }
        SEAM(P + 0);
        for (int mrep = 0; mrep < 1 + ((DBG_DOUBLE >> 1) & 1); ++mrep) {
        if (IN(P + 1)) for (int rp1 = 0; rp1 < 1 + ((DBG_DOUBLE >> 10) & 1); ++rp1) {
            PHASE_IDS(); kaptr ka = ka_fresh(); unsigned char* ws = KA_WS(ka); __syncthreads();
#if !defined(DBG_NO_RET)
            for (int rq = 0; rq < 1 + ((DBG_DOUBLE >> 13) & 1); ++rq) { __syncthreads(); if (PM(4)) ret_scan(WSP(const bf16, WS_PROJ), WSP(bf16, WS_ST), WSP(bf16, WS_FS), KA_IN(ka, 16) + l * 16, lds, vcu, G, tid, wave); }
            if (DBG_DOUBLE & (3 << 13)) { XcdBarrier b3 = bar; asm volatile("" : "+s"(b3.x)); xcd_barrier(b3); }
#endif
#if !defined(DBG_NO_ATT)
            for (int rq = 0; rq < 1 + ((DBG_DOUBLE >> 14) & 1); ++rq) { __syncthreads(); if (PM(5)) attn_phase(WSP(const bf16, WS_PROJ), WSP(bf16, WS_MIXED), KA_IN(ka, 5) + l * 3720, KA_IN(ka, 17) + l * 1024, lds, vcu, G, wave, lane); }
            if (DBG_DOUBLE & 16) { __syncthreads(); attn_phase(WSP(const bf16, WS_PROJ), WSP(bf16, WS_MIXED), KA_IN(ka, 5) + l * 3720, KA_IN(ka, 17) + l * 1024, lds, vcu, G, wave, lane); }
#endif
            __syncthreads();
#if !defined(DBG_NO_HY)
            if (PM(6)) hyena_transpose(WSP(const bf16, WS_PROJ), KA_IN(ka, 6) + l * 9216, KA_IN(ka, 7) + l * 3072, WSP(float, WS_HYT), lds, gw, ngw, wave, lane);
            if (DBG_DOUBLE & 32) { __syncthreads(); hyena_transpose(WSP(const bf16, WS_PROJ), KA_IN(ka, 6) + l * 9216, KA_IN(ka, 7) + l * 3072, WSP(float, WS_HYT), lds, gw, ngw, wave, lane); }
            if (PM(7)) filter_assembly(KA_IN(ka, 13) + (size_t)l * 64 * 4096, KA_IN(ka, 14) + l * 4096, KA_IN(ka, 15) + l * 2048, WSP(const float, WS_H2) + (size_t)l * 10240 * 64, WSP(float, WS_FILT), lds, vcu, G, tid, wave, lane);
            if (DBG_DOUBLE & 32) { __syncthreads(); filter_assembly(KA_IN(ka, 13) + (size_t)l * 64 * 4096, KA_IN(ka, 14) + l * 4096, KA_IN(ka, 15) + l * 2048, WSP(const float, WS_H2) + (size_t)l * 10240 * 64, WSP(float, WS_FILT), lds, vcu, G, tid, wave, lane); }
#endif
        }
        SEAM(P + 1);
        if (IN(P + 2)) for (int rp2 = 0; rp2 < 1 + ((DBG_DOUBLE >> 11) & 1); ++rp2) {
            PHASE_IDS(); kaptr ka = ka_fresh(); unsigned char* ws = KA_WS(ka); __syncthreads();
#if !defined(DBG_NO_HY)
            if (PM(8)) { hyena_conv_s2(WSP(const float, WS_HYT), WSP(float, WS_ZOUT), WSP(const float, WS_FILT), WSP(const cf2, WS_TW), lds, vcu, G, tid); hyena_conv_p(WSP(const float, WS_HYT), WSP(float, WS_ZOUT), WSP(const float, WS_FILT), WSP(const unsigned char, WS_FMTAB), lds, vcu, G, tid); }
            if (DBG_DOUBLE & 256) hyena_conv(WSP(const float, WS_HYT), WSP(float, WS_ZOUT), WSP(const float, WS_FILT), WSP(const cf2, WS_TW), lds, vcu, G, tid);
            if (DBG_DOUBLE & 512) hyena_conv_p(WSP(const float, WS_HYT), WSP(float, WS_ZOUT), WSP(const float, WS_FILT), WSP(const unsigned char, WS_FMTAB), lds, vcu, G, tid);
#endif
#if !defined(DBG_NO_RET)
            if (PM(9)) ret_fix(WSP(bf16, WS_ST), WSP(const bf16, WS_FS), KA_IN(ka, 16) + l * 16, vcu, G, tid);
#endif
        }
        SEAM(P + 2);
        if (IN(P + 3)) for (int rp3 = 0; rp3 < 1 + ((DBG_DOUBLE >> 12) & 1); ++rp3) {
            PHASE_IDS(); kaptr ka = ka_fresh(); unsigned char* ws = KA_WS(ka); __syncthreads();
#if !defined(DBG_NO_RET)
            if (PM(9)) ret_out(WSP(const bf16, WS_PROJ), WSP(const bf16, WS_ST), WSP(bf16, WS_MIXED), KA_IN(ka, 16) + l * 16, lds, vcu, G, tid, wave);
#endif
#if !defined(DBG_NO_HY)
            if (PM(10)) hyena_norm(WSP(const float, WS_ZOUT), KA_IN(ka, 18) + l * 1024, WSP(bf16, WS_MIXED), lds, vcu, G, wave, lane);
            if (DBG_DOUBLE & 128) { __syncthreads(); hyena_norm(WSP(const float, WS_ZOUT), KA_IN(ka, 18) + l * 1024, WSP(bf16, WS_MIXED), lds, vcu, G, wave, lane); }
#endif
#if defined(DBG_NO_ATT) || defined(DBG_NO_HY) || defined(DBG_NO_RET)
            for (size_t i = (size_t)(bx * NT + tid); i < (size_t)MTOK * DM / 8; i += (size_t)G * NT) { const int col = (int)((i * 8) % DM); bool z = false;
#if defined(DBG_NO_ATT)
                z |= col < 1024;
#endif
#if defined(DBG_NO_HY)
                z |= (col >= 1024 && col < 2048);
#endif
#if defined(DBG_NO_RET)
                z |= col >= 2048;
#endif
                if (z) WSP(v4u, WS_MIXED)[i] = (v4u){0u, 0u, 0u, 0u}; }
#endif
        }
        SEAM(P + 3);
        }
        if (IN(P + 4)) {
            PHASE_IDS(); kaptr ka = ka_fresh(); unsigned char* ws = KA_WS(ka);
            pg8::Gemm g{WSP(bf16, WS_MIXED), WSP(const bf16, WS_WOUT), MTOK, DM, DM}; pg8::StaticOrder S; S.init(MTOK, DM, G, bx);
            pg8::EpiRes E{WSP(pg8::bf16_t, WS_XR), WSP(const pg8::bf16_t, WS_XB), ALPHA};
            if (PM(11)) pg8::gemm_phase<pg8::EpiRes, pg8::StaticOrder, true, true>(lds, g, S, E);
        }
        SEAM(P + 4);
        if (IN(P + 5)) {
            PHASE_IDS(); kaptr ka = ka_fresh(); unsigned char* ws = KA_WS(ka);
            for (int m = gw; m < MTOK; m += ngw) ln_row_qb(WSP(const bf16, WS_XR) + (size_t)m * DM, KA_IN(ka, 20) + l * DM, KA_IN(ka, 21) + l * DM, WSP(signed char, WS_XB) + (size_t)m * DM, WSP(float, WS_ROWINV) + m, WSP(float, WS_STATS) + 2 * m, lane);
        }
        SEAM(P + 5);
        if (IN(P + 6)) {
            PHASE_IDS(); kaptr ka = ka_fresh(); unsigned char* ws = KA_WS(ka);
            pg8::Gemm g{WSP(bf16, WS_XB), WSP(const bf16, WS_WFI), MTOK, NFF2, DM}; pg8::StaticOrder S; S.init(MTOK, NFF2, G, bx);
            pg8::EpiSwigluQ E{WSP(bf16, WS_PROJ), WSP(const float, WS_ROWINV), WSP(const unsigned, WS_CTL) + CW_WMAX + l};
            if (PM(12)) pg8::gemm_phase<pg8::EpiSwigluQ, pg8::StaticOrder, true, true, true>(lds, g, S, E);
        }
        SEAM(P + 6);
        if (IN(P + 7)) {
            PHASE_IDS(); kaptr ka = ka_fresh(); unsigned char* ws = KA_WS(ka);
            for (int m = gw; m < MTOK; m += ngw) quant_row_h(WSP(const bf16, WS_PROJ) + (size_t)m * DFF, WSP(signed char, WS_HQ) + (size_t)m * DFF, WSP(float, WS_ROWINV2) + m, lane);
        }
        SEAM(P + 7);
        if (IN(P + 8)) {
            PHASE_IDS(); kaptr ka = ka_fresh(); unsigned char* ws = KA_WS(ka);
            pg8::Gemm g{WSP(bf16, WS_HQ), WSP(const bf16, WS_WFO), MTOK, DM, DFF}; pg8::StaticOrder S; S.init(MTOK, DM, G, bx);
            pg8::EpiResQ E{WSP(pg8::bf16_t, WS_XR), ALPHA, WSP(const float, WS_ROWINV2), WSP(const unsigned, WS_CTL) + CW_WMAX + 2 + l, WSP(const float, WS_STATS), KA_IN(ka, 20) + l * DM, KA_IN(ka, 21) + l * DM};
            if (PM(13)) pg8::gemm_phase<pg8::EpiResQ, pg8::StaticOrder, true, true, true>(lds, g, S, E);
        }
        SEAM(P + 8);
        if (IN(P + 9)) {
            PHASE_IDS(); kaptr ka = ka_fresh(); unsigned char* ws = KA_WS(ka); float* xres = KA_OUT(ka);
            if (l == 0) { for (int m = gw; m < MTOK; m += ngw) ln_row_b_in(WSP(const bf16, WS_XR) + (size_t)m * DM, KA_IN(ka, 24), KA_IN(ka, 25), WSP(bf16, WS_XB) + (size_t)m * DM, WSP(signed char, WS_XQ) + (size_t)m * DM, WSP(float, WS_ROWINV3) + m, lane); }
            else { for (int m = gw; m < MTOK; m += ngw) ln_row_b<true>(WSP(const bf16, WS_XR) + (size_t)m * DM, KA_IN(ka, 24) + DM, KA_IN(ka, 25) + DM, xres + (size_t)m * DM, (bf16*)nullptr, lane); }
            if (l == 0 && PM(2)) convert_weights(KA_IN(ka, 4) + (size_t)DM * NIN, KA_IN(ka, 19) + (size_t)DM * DM, KA_IN(ka, 22) + (size_t)DM * NFF2, KA_IN(ka, 23) + (size_t)DFF * DM, ws, WSP(const unsigned, WS_CTL) + CW_WMAX + 1, WSP(const unsigned, WS_CTL) + CW_CMAX + NIN, lds, gw, ngw, wave, lane);
        }
        SEAM(P + 9);
    }
#undef IN
#undef SEAM
}

extern "C" void kernel_launch(void* const* d_in, const int* in_sizes, int n_in, void* d_out, int out_size, void* d_ws, size_t ws_size, hipStream_t stream) {
    static int grid = 0;
    if (grid == 0) {
        if (n_in != 26 || out_size != MTOK * DM || ws_size < WS_END) { fprintf(stderr, "kernel_launch: unexpected problem (n_in %d, out %d, ws %zu < %zu)\n", n_in, out_size, ws_size, (size_t)WS_END); grid = -1; return; }
        int dev = 0, cus = 0, per_cu = 0;
        if (hipGetDevice(&dev) != hipSuccess || hipDeviceGetAttribute(&cus, hipDeviceAttributeMultiprocessorCount, dev) != hipSuccess) { grid = -1; return; }
        if (hipFuncSetAttribute((const void*)fwd_kernel, hipFuncAttributeMaxDynamicSharedMemorySize, LDS_BYTES) != hipSuccess) { fprintf(stderr, "kernel_launch: hipFuncSetAttribute failed\n"); grid = -1; return; }
        if (hipOccupancyMaxActiveBlocksPerMultiprocessor(&per_cu, (const void*)fwd_kernel, NT, LDS_BYTES) != hipSuccess || per_cu < 1) fprintf(stderr, "kernel_launch: occupancy query says %d\n", per_cu);
        (void)hipGetLastError();
        grid = cus;
    }
    if (grid < 0) return;
    if (hipMemsetAsync((char*)d_ws + WS_CTL, 0, CTL_ZERO_BYTES, stream) != hipSuccess) return;
    Args a{};
    for (int i = 0; i < 26; ++i) a.in[i] = (const float*)d_in[i];
    a.out = (float*)d_out; a.ws = (unsigned char*)d_ws; a.pad = 0;
#if MK_N_LAUNCHES == 1
    a.ph_lo = 0; a.ph_hi = N_PHASES; a.li = 0;
    hipLaunchKernelGGL(fwd_kernel, dim3(grid), dim3(NT), LDS_BYTES, stream, a);
#else
    for (int p = 0; p < N_PHASES; ++p) { a.ph_lo = p; a.ph_hi = p + 1; a.li = 0; hipLaunchKernelGGL(fwd_kernel, dim3(grid), dim3(NT), LDS_BYTES, stream, a); }
#endif
}
```

```cpp
#include <hip/hip_runtime.h>
#include <cstdio>
#include <cstdint>
namespace pg8 {
#define PG8_LAS __attribute__((address_space(3)))
typedef unsigned short bf16_t;
typedef short bf16x8 __attribute__((ext_vector_type(8)));
typedef float f32x4 __attribute__((ext_vector_type(4)));
typedef unsigned u32x4 __attribute__((ext_vector_type(4)));
constexpr int BM = 256, BK = 64, HALF = 128, HTB = HALF * BK * 2  , STAGE_BYTES = 8 * HTB, NXCD = 8, WGM = 8;

__host__ __device__ __forceinline__ int lds_byte(int r, int c) { const int st = (r >> 4) * 2 + (c >> 5), rr = r & 15, cc = c & 31, ob = rr * 64 + cc * 2; return st * 1024 + (ob ^ (((ob >> 9) & 1) << 5)); }
__host__ __device__ __forceinline__ void stage_rc(int b, int& R, int& C) { const int st = b / 1024, sb = b % 1024, swz = sb ^ (((sb >> 9) & 1) << 5); R = (st >> 1) * 16 + swz / 64; C = (st & 1) * 32 + (swz % 64) / 2; }
__host__ __device__ __forceinline__ int perm32(int rho) { const int n = rho >> 4, i = rho & 15; return 8 * (i >> 2) + 4 * n + (i & 3); }

struct Unit { int pm, pn; };
struct Gemm { const bf16_t* A; const bf16_t* Bt; int M, N, K; };

struct StaticOrder {
    int nM, nN, nwg, G, c;
    __host__ __device__ void init(int M, int N, int G_, int c_) { nM = M / BM; nN = N / BM; nwg = nM * nN; G = G_; c = c_; }
    __host__ __device__ bool next(int i, Unit& u) const {
        const long L = (long)i * G + c; if (L >= nwg) return false;
        int wgid = (int)L; { const int q = nwg / NXCD, r = nwg % NXCD, xcd = wgid % NXCD, off = wgid / NXCD; wgid = (xcd < r ? xcd * (q + 1) : r * (q + 1) + (xcd - r) * q) + off; }
        const int nig = WGM * nN, gid = wgid / nig, fm = gid * WGM, gsz = (nM - fm) < WGM ? (nM - fm) : WGM;
        u.pm = fm + ((wgid % nig) % gsz); u.pn = (wgid % nig) / gsz; return true;
    }
    __device__ __forceinline__ void a_ready(const Unit&) const {}
    __device__ __forceinline__ void done(const Unit&) const {}
};

__device__ __forceinline__ unsigned cvt_pk_bf16(float lo, float hi) { unsigned r; asm volatile("v_cvt_pk_bf16_f32 %0, %1, %2" : "=v"(r) : "v"(lo), "v"(hi)); return r; }

typedef int i32x4 __attribute__((ext_vector_type(4)));
template <bool I8> struct AccSel { typedef f32x4 type; };
template <> struct AccSel<true> { typedef i32x4 type; };
typedef _Float16 f16x8 __attribute__((ext_vector_type(8)));
template <class Epi, class Sched, bool ALIGN_EPI = false, bool SP2 = false, bool I8 = false, bool F16 = false>
__device__ __forceinline__ void gemm_phase(PG8_LAS unsigned char* lds, const Gemm g, const Sched& S, const Epi& E) {
    int tid_l = threadIdx.x; asm volatile("" : "+v"(tid_l));
    const int tid = tid_l, wid = __builtin_amdgcn_readfirstlane(tid >> 6), lane = tid & 63, wr = wid >> 2, wc = wid & 3, fr = lane & 15, fq = lane >> 4;
    const int K = I8 ? g.K / 2 : g.K, nt = K / BK;
    unsigned voffA[2], voffB[2];
#pragma unroll
    for (int i = 0; i < 2; ++i) { int R, C; stage_rc(tid * 16 + i * 8192, R, C); const int Rb = Epi::PERM ? ((R & ~31) + perm32(R & 31)) : R;
        voffA[i] = (unsigned)(R * K + C) * 2u; voffB[i] = (unsigned)(Rb * K + C) * 2u; }
    const size_t kstep = (size_t)(BK * 2);
    const size_t hstep = (size_t)HALF * K * 2;
    const size_t tstep = 2 * hstep;
    const unsigned ldsw = (unsigned)wid * 1024u;
    const int aoff = lds_byte(wr * 64 + fr, fq * 8), boff = lds_byte(wc * 32 + fr, fq * 8);
#define PG8_SA(b, h) (((b) * 2 + (h)) * HTB)
#define PG8_SB(b, h) ((4 + (b) * 2 + (h)) * HTB)
#define PG8_STAGE(bufoff, gbase, voff) do { _Pragma("unroll") for (int _i = 0; _i < 2; ++_i) \
        __builtin_amdgcn_global_load_lds((const unsigned*)((const char*)(gbase) + (voff)[_i]), (PG8_LAS unsigned*)(lds + (bufoff) + ldsw + _i * 8192), 16, 0, 0); } while (0)
#define PG8_LDA(dst, b, h) do { _Pragma("unroll") for (int m = 0; m < 4; ++m) _Pragma("unroll") for (int k = 0; k < 2; ++k) dst[m][k] = *(const PG8_LAS bf16x8*)(lds + PG8_SA(b, h) + aoff + m * 2048 + k * 1024); } while (0)
#define PG8_LDB(dst, b, h) do { _Pragma("unroll") for (int n = 0; n < 2; ++n) _Pragma("unroll") for (int k = 0; k < 2; ++k) dst[n][k] = *(const PG8_LAS bf16x8*)(lds + PG8_SB(b, h) + boff + n * 2048 + k * 1024); } while (0)
#define PG8_MMA(ai, bj, At, Bt) do { __builtin_amdgcn_s_setprio(1); _Pragma("unroll") for (int m = 0; m < 4; ++m) _Pragma("unroll") for (int n = 0; n < 2; ++n) _Pragma("unroll") for (int k = 0; k < 2; ++k) \
        { if constexpr (I8) acc[ai][bj][m][n] = __builtin_amdgcn_mfma_i32_16x16x64_i8(__builtin_bit_cast(i32x4, Bt[n][k]), __builtin_bit_cast(i32x4, At[m][k]), acc[ai][bj][m][n], 0, 0, 0); \
          else if constexpr (F16) acc[ai][bj][m][n] = __builtin_amdgcn_mfma_f32_16x16x32_f16(__builtin_bit_cast(f16x8, Bt[n][k]), __builtin_bit_cast(f16x8, At[m][k]), acc[ai][bj][m][n], 0, 0, 0); \
          else acc[ai][bj][m][n] = __builtin_amdgcn_mfma_f32_16x16x32_bf16(Bt[n][k], At[m][k], acc[ai][bj][m][n], 0, 0, 0); } __builtin_amdgcn_s_setprio(0); } while (0)
#define PG8_WAIT_V(n) asm volatile("s_waitcnt vmcnt(" #n ")" ::: "memory")
#define PG8_WAIT_L(n) asm volatile("s_waitcnt lgkmcnt(" #n ")" ::: "memory")
#define PG8_BAR __builtin_amdgcn_s_barrier()
#define PG8_SCHED __builtin_amdgcn_sched_barrier(0)
    Unit cur, nxt; int ui = 0;
    if (!S.next(0, cur)) return;
    typedef typename AccSel<I8>::type accv_t;
    accv_t acc[2][2][4][2];
#pragma unroll
    for (int a = 0; a < 2; ++a)
#pragma unroll
        for (int b = 0; b < 2; ++b)
#pragma unroll
            for (int m = 0; m < 4; ++m)
#pragma unroll
                for (int n = 0; n < 2; ++n) acc[a][b][m][n] = (accv_t){0, 0, 0, 0};
    bf16x8 At[4][2], B0[2][2], B1[2][2];
    const char* cA = (const char*)g.A + (size_t)cur.pm * tstep; const char* cB = (const char*)g.Bt + (size_t)cur.pn * tstep;
    S.a_ready(cur);
    if constexpr (SP2) {
        PG8_STAGE(PG8_SB(0, 0), cB, voffB); PG8_STAGE(PG8_SB(0, 1), cB + hstep, voffB); PG8_STAGE(PG8_SA(0, 0), cA, voffA); PG8_STAGE(PG8_SA(0, 1), cA + hstep, voffA);
        if (wr == 1) PG8_BAR;
        PG8_WAIT_V(2); PG8_BAR;
        PG8_STAGE(PG8_SB(1, 0), cB + kstep, voffB); PG8_STAGE(PG8_SA(1, 0), cA + kstep, voffA); PG8_STAGE(PG8_SB(1, 1), cB + hstep + kstep, voffB);
        PG8_WAIT_V(6); PG8_BAR;
    } else {
        PG8_STAGE(PG8_SB(0, 0), cB, voffB); PG8_STAGE(PG8_SA(0, 0), cA, voffA); PG8_STAGE(PG8_SB(0, 1), cB + hstep, voffB); PG8_STAGE(PG8_SA(0, 1), cA + hstep, voffA);
        if (wr == 1) PG8_BAR;
        PG8_WAIT_V(4); PG8_BAR;
        PG8_STAGE(PG8_SB(1, 0), cB + kstep, voffB); PG8_STAGE(PG8_SA(1, 0), cA + kstep, voffA); PG8_STAGE(PG8_SB(1, 1), cB + hstep + kstep, voffB);
        PG8_WAIT_V(6); PG8_BAR;
    }
    for (;;) {
        const bool has_next = S.next(ui + 1, nxt);
        const char* nA = has_next ? (const char*)g.A + (size_t)nxt.pm * tstep : cA; const char* nB = has_next ? (const char*)g.Bt + (size_t)nxt.pn * tstep : cB;
        for (int t = 0; t < nt; t += 2) {
            const bool last = (t == nt - 2);
            const char* a1 = cA + (size_t)(t + 1) * kstep;
            const char* a2 = last ? nA : cA + (size_t)(t + 2) * kstep; const char* b2 = last ? nB : cB + (size_t)(t + 2) * kstep;
            const char* a3 = a2 + kstep; const char* b3 = b2 + kstep;
            if (last && has_next) S.a_ready(nxt);
            if constexpr (SP2) {
            PG8_LDB(B0, 0, 0); PG8_LDB(B1, 0, 1); PG8_SCHED; PG8_LDA(At, 0, 0); PG8_STAGE(PG8_SA(1, 1), a1 + hstep, voffA);
            PG8_WAIT_V(8); PG8_WAIT_L(0); PG8_BAR; PG8_MMA(0, 0, At, B0); PG8_MMA(0, 1, At, B1); PG8_BAR; PG8_SCHED;
            PG8_LDA(At, 0, 1); PG8_STAGE(PG8_SB(0, 0), b2, voffB); PG8_STAGE(PG8_SB(0, 1), b2 + hstep, voffB); PG8_STAGE(PG8_SA(0, 0), a2, voffA);
            PG8_WAIT_V(8); PG8_WAIT_L(0); PG8_BAR; PG8_MMA(1, 0, At, B0); PG8_MMA(1, 1, At, B1); PG8_BAR; PG8_SCHED;
            PG8_LDB(B0, 1, 0); PG8_LDB(B1, 1, 1); PG8_SCHED; PG8_LDA(At, 1, 0); PG8_STAGE(PG8_SA(0, 1), a2 + hstep, voffA);
            PG8_WAIT_V(8); PG8_WAIT_L(0); PG8_BAR; PG8_MMA(0, 0, At, B0); PG8_MMA(0, 1, At, B1); PG8_BAR; PG8_SCHED;
            PG8_LDA(At, 1, 1); PG8_STAGE(PG8_SB(1, 0), b3, voffB); PG8_STAGE(PG8_SB(1, 1), b3 + hstep, voffB); PG8_STAGE(PG8_SA(1, 0), a3, voffA);
            PG8_WAIT_V(8); PG8_WAIT_L(0); PG8_BAR; PG8_MMA(1, 0, At, B0); PG8_MMA(1, 1, At, B1); PG8_BAR; PG8_SCHED;
            } else {
            PG8_LDB(B0, 0, 0); PG8_SCHED; PG8_LDA(At, 0, 0); PG8_STAGE(PG8_SA(1, 1), a1 + hstep, voffA);
            PG8_WAIT_L(8); PG8_BAR; PG8_WAIT_L(0); PG8_MMA(0, 0, At, B0); PG8_BAR; PG8_SCHED;
            PG8_LDB(B1, 0, 1); PG8_STAGE(PG8_SB(0, 0), b2, voffB);
            PG8_BAR; PG8_WAIT_L(0); PG8_MMA(0, 1, At, B1); PG8_BAR;
            PG8_LDA(At, 0, 1); PG8_STAGE(PG8_SA(0, 0), a2, voffA);
            PG8_BAR; PG8_WAIT_L(0); PG8_MMA(1, 0, At, B0); PG8_BAR; PG8_SCHED;
            PG8_STAGE(PG8_SB(0, 1), b2 + hstep, voffB);
            PG8_WAIT_V(6); PG8_BAR; PG8_MMA(1, 1, At, B1); PG8_BAR;
            PG8_LDB(B0, 1, 0); PG8_SCHED; PG8_LDA(At, 1, 0); PG8_STAGE(PG8_SA(0, 1), a2 + hstep, voffA);
            PG8_WAIT_L(8); PG8_BAR; PG8_WAIT_L(0); PG8_MMA(0, 0, At, B0); PG8_BAR; PG8_SCHED;
            PG8_LDB(B1, 1, 1); PG8_STAGE(PG8_SB(1, 0), b3, voffB);
            PG8_BAR; PG8_WAIT_L(0); PG8_MMA(0, 1, At, B1); PG8_BAR;
            PG8_LDA(At, 1, 1); PG8_STAGE(PG8_SA(1, 0), a3, voffA);
            PG8_BAR; PG8_WAIT_L(0); PG8_MMA(1, 0, At, B0); PG8_BAR; PG8_SCHED;
            PG8_STAGE(PG8_SB(1, 1), b3 + hstep, voffB);
            PG8_WAIT_V(6); PG8_BAR; PG8_MMA(1, 1, At, B1); PG8_BAR;
            }
        }
        if constexpr (ALIGN_EPI) { if (wr == 0) PG8_BAR; }
        if constexpr (!Epi::AFTER_DRAIN) { E(acc, cur, wr, wc, fr, fq); S.done(cur); }
        if (!has_next) break;
#pragma unroll
        for (int a = 0; a < 2; ++a)
#pragma unroll
            for (int b = 0; b < 2; ++b)
#pragma unroll
                for (int m = 0; m < 4; ++m)
#pragma unroll
                    for (int n = 0; n < 2; ++n) acc[a][b][m][n] = (accv_t){0, 0, 0, 0};
        cur = nxt; cA = nA; cB = nB; ++ui;
        if constexpr (ALIGN_EPI) { if (wr == 1) PG8_BAR; }
    }
    PG8_WAIT_V(0);
    if constexpr (!ALIGN_EPI) { if (wr == 0) PG8_BAR; }
    PG8_BAR;
    if constexpr (Epi::AFTER_DRAIN) { E.fused(acc, cur, wr, wc, fr, fq, lds, wid, lane); S.done(cur); }
#undef PG8_SA
#undef PG8_SB
#undef PG8_STAGE
#undef PG8_LDA
#undef PG8_LDB
#undef PG8_MMA
#undef PG8_WAIT_V
#undef PG8_WAIT_L
#undef PG8_BAR
#undef PG8_SCHED
}

struct EpiProj {
    static constexpr bool PERM = true, AFTER_DRAIN = false;
    bf16_t* O; const float* rope;
    __device__ __forceinline__ void operator()(const f32x4 (&acc)[2][2][4][2], const Unit& u, int wr, int wc, int fr, int fq) const {
        const int pn = u.pn + 16;
        const int row0 = u.pm * BM + wr * 64 + fr, col0 = pn * BM + wc * 32 + 8 * fq;
        const bool rot = (pn >= 24) && (pn < 40);
        const float ksc = (pn >= 32 && pn < 40) ? 0.0625f : 1.0f;
#pragma unroll
        for (int ai = 0; ai < 2; ++ai)
#pragma unroll
            for (int m = 0; m < 4; ++m) {
                const int row = row0 + ai * HALF + m * 16;
                bf16_t* rowp = O + (size_t)row * 14336 + col0;
                f32x4 a0 = acc[ai][0][m][0], a1 = acc[ai][0][m][1], b0 = acc[ai][1][m][0], b1 = acc[ai][1][m][1];
                if (rot) {
                    const int pos = row < 16384 ? (row & 2047) : (row - 16384);
                    const f32x4* rp = (const f32x4*)(rope + ((size_t)pos * 128 + wc * 32 + 8 * fq) * 2);
                    const f32x4 r0 = rp[0], r1 = rp[1], r2 = rp[2], r3 = rp[3];
                    const f32x4 c0 = {r0.x, r0.z, r1.x, r1.z}, s0 = {r0.y, r0.w, r1.y, r1.w}, c1 = {r2.x, r2.z, r3.x, r3.z}, s1 = {r2.y, r2.w, r3.y, r3.w};
                    const f32x4 na0 = a0 * c0 - b0 * s0, nb0 = a0 * s0 + b0 * c0, na1 = a1 * c1 - b1 * s1, nb1 = a1 * s1 + b1 * c1;
                    a0 = na0 * ksc; b0 = nb0 * ksc; a1 = na1 * ksc; b1 = nb1 * ksc;
                }
                u32x4 w0, w1;
                w0.x = cvt_pk_bf16(a0[0], a0[1]); w0.y = cvt_pk_bf16(a0[2], a0[3]); w0.z = cvt_pk_bf16(a1[0], a1[1]); w0.w = cvt_pk_bf16(a1[2], a1[3]);
                w1.x = cvt_pk_bf16(b0[0], b0[1]); w1.y = cvt_pk_bf16(b0[2], b0[3]); w1.z = cvt_pk_bf16(b1[0], b1[1]); w1.w = cvt_pk_bf16(b1[2], b1[3]);
                *(u32x4*)(rowp) = w0; *(u32x4*)(rowp + HALF) = w1;
            }
    }
};
__device__ __forceinline__ f32x4 bf4lo(const u32x4 w) { f32x4 r; r.x = __builtin_bit_cast(float, w.x << 16); r.y = __builtin_bit_cast(float, w.x & 0xffff0000u); r.z = __builtin_bit_cast(float, w.y << 16); r.w = __builtin_bit_cast(float, w.y & 0xffff0000u); return r; }
__device__ __forceinline__ f32x4 bf4hi(const u32x4 w) { f32x4 r; r.x = __builtin_bit_cast(float, w.z << 16); r.y = __builtin_bit_cast(float, w.z & 0xffff0000u); r.z = __builtin_bit_cast(float, w.w << 16); r.w = __builtin_bit_cast(float, w.w & 0xffff0000u); return r; }
__device__ __forceinline__ u32x4 pk8(const f32x4 a, const f32x4 b) { u32x4 w; w.x = cvt_pk_bf16(a[0], a[1]); w.y = cvt_pk_bf16(a[2], a[3]); w.z = cvt_pk_bf16(b[0], b[1]); w.w = cvt_pk_bf16(b[2], b[3]); return w; }
typedef float f2v_t __attribute__((ext_vector_type(2))); typedef _Float16 h2v_t __attribute__((ext_vector_type(2)));
__device__ __forceinline__ unsigned pkh(float a, float b) { const f2v_t f = {a, b}; const h2v_t h = __builtin_convertvector(f, h2v_t); return __builtin_bit_cast(unsigned, h); }
__device__ __forceinline__ float hlo(unsigned w) { return (float)__builtin_bit_cast(_Float16, (unsigned short)(w & 0xffffu)); }
__device__ __forceinline__ float hhi(unsigned w) { return (float)__builtin_bit_cast(_Float16, (unsigned short)(w >> 16)); }
__device__ __forceinline__ u32x4 pk8h(const f32x4 a, const f32x4 b) { u32x4 w; w.x = pkh(a[0], a[1]); w.y = pkh(a[2], a[3]); w.z = pkh(b[0], b[1]); w.w = pkh(b[2], b[3]); return w; }
__device__ __forceinline__ f32x4 h4lo(const u32x4 w) { return (f32x4){hlo(w.x), hhi(w.x), hlo(w.y), hhi(w.y)}; }
__device__ __forceinline__ f32x4 h4hi(const u32x4 w) { return (f32x4){hlo(w.z), hhi(w.z), hlo(w.w), hhi(w.w)}; }
struct EpiRes {
    static constexpr bool PERM = true, AFTER_DRAIN = false;
    bf16_t* X; const bf16_t* Y; float alpha;
    __device__ __forceinline__ void operator()(const f32x4 (&acc)[2][2][4][2], const Unit& u, int wr, int wc, int fr, int fq) const {
        const int row0 = u.pm * BM + wr * 64 + fr, col0 = u.pn * BM + wc * 32 + 8 * fq;
#pragma unroll
        for (int ai = 0; ai < 2; ++ai) {
            u32x4 y[4][2];
#pragma unroll
            for (int m = 0; m < 4; ++m) { const bf16_t* yp = Y + (size_t)(row0 + ai * HALF + m * 16) * 4096 + col0; y[m][0] = *(const u32x4*)yp; y[m][1] = *(const u32x4*)(yp + HALF); }
#pragma unroll
            for (int m = 0; m < 4; ++m) { bf16_t* rowp = X + (size_t)(row0 + ai * HALF + m * 16) * 4096 + col0;
#pragma unroll
                for (int bj = 0; bj < 2; ++bj) *(u32x4*)(rowp + bj * HALF) = pk8h(h4lo(y[m][bj]) * alpha + acc[ai][bj][m][0], h4hi(y[m][bj]) * alpha + acc[ai][bj][m][1]); }
            asm volatile("" ::: "memory");
        }
    }
};
struct EpiSwiglu {
    static constexpr bool PERM = true, AFTER_DRAIN = false;
    bf16_t* H;
    __device__ __forceinline__ void operator()(const f32x4 (&acc)[2][2][4][2], const Unit& u, int wr, int wc, int fr, int fq) const {
        const int row0 = u.pm * BM + wr * 64 + fr, col0 = u.pn * HALF + wc * 32 + 8 * fq;
#pragma unroll
        for (int ai = 0; ai < 2; ++ai)
#pragma unroll
            for (int m = 0; m < 4; ++m) {
                bf16_t* rowp = H + (size_t)(row0 + ai * HALF + m * 16) * 11008 + col0;
                f32x4 h0, h1;
#pragma unroll
                for (int j = 0; j < 4; ++j) {
                    const float g0 = acc[ai][0][m][0][j], g1 = acc[ai][0][m][1][j];
                    h0[j] = g0 * __builtin_amdgcn_rcpf(1.0f + __expf(-g0)) * acc[ai][1][m][0][j];
                    h1[j] = g1 * __builtin_amdgcn_rcpf(1.0f + __expf(-g1)) * acc[ai][1][m][1][j];
                }
                u32x4 w; w.x = cvt_pk_bf16(h0[0], h0[1]); w.y = cvt_pk_bf16(h0[2], h0[3]); w.z = cvt_pk_bf16(h1[0], h1[1]); w.w = cvt_pk_bf16(h1[2], h1[3]);
                *(u32x4*)(rowp) = w;
            }
    }
};
struct EpiSwigluQ {
    static constexpr bool PERM = true, AFTER_DRAIN = false;
    bf16_t* H; const float* rowinv; const unsigned* wmax_bits;
    __device__ __forceinline__ void operator()(const i32x4 (&acc)[2][2][4][2], const Unit& u, int wr, int wc, int fr, int fq) const {
        const int row0 = u.pm * BM + wr * 64 + fr, col0 = u.pn * HALF + wc * 32 + 8 * fq;
        const float wdq = __builtin_bit_cast(float, *wmax_bits) * (1.0f / 127.0f);
#pragma unroll
        for (int ai = 0; ai < 2; ++ai)
#pragma unroll
            for (int m = 0; m < 4; ++m) {
                const int row = row0 + ai * HALF + m * 16;
                const float f = rowinv[row] * wdq;
                bf16_t* rowp = H + (size_t)row * 11008 + col0;
                f32x4 h0, h1;
#pragma unroll
                for (int j = 0; j < 4; ++j) {
                    const float g0 = (float)acc[ai][0][m][0][j] * f, g1 = (float)acc[ai][0][m][1][j] * f;
                    h0[j] = g0 * __builtin_amdgcn_rcpf(1.0f + __expf(-g0)) * ((float)acc[ai][1][m][0][j] * f);
                    h1[j] = g1 * __builtin_amdgcn_rcpf(1.0f + __expf(-g1)) * ((float)acc[ai][1][m][1][j] * f);
                }
                u32x4 w; w.x = cvt_pk_bf16(h0[0], h0[1]); w.y = cvt_pk_bf16(h0[2], h0[3]); w.z = cvt_pk_bf16(h1[0], h1[1]); w.w = cvt_pk_bf16(h1[2], h1[3]);
                *(u32x4*)(rowp) = w;
            }
    }
};
struct EpiResQ {
    static constexpr bool PERM = true, AFTER_DRAIN = false;
    bf16_t* X; float alpha; const float* rowinv; const unsigned* wmax_bits; const float* stats; const float* g; const float* b;
    __device__ __forceinline__ void operator()(const i32x4 (&acc)[2][2][4][2], const Unit& u, int wr, int wc, int fr, int fq) const {
        const int row0 = u.pm * BM + wr * 64 + fr, col0 = u.pn * BM + wc * 32 + 8 * fq;
        const float wdq = __builtin_bit_cast(float, *wmax_bits) * (1.0f / 127.0f);
#pragma unroll
        for (int ai = 0; ai < 2; ++ai) {
            u32x4 y[4][2]; float mean[4], rstd[4], f[4];
#pragma unroll
            for (int m = 0; m < 4; ++m) { const int row = row0 + ai * HALF + m * 16; const bf16_t* yp = X + (size_t)row * 4096 + col0; y[m][0] = *(const u32x4*)yp; y[m][1] = *(const u32x4*)(yp + HALF);
                mean[m] = stats[2 * row]; rstd[m] = stats[2 * row + 1]; f[m] = rowinv[row] * wdq; }
#pragma unroll
            for (int m = 0; m < 4; ++m) { bf16_t* rowp = X + (size_t)(row0 + ai * HALF + m * 16) * 4096 + col0;
#pragma unroll
                for (int bj = 0; bj < 2; ++bj) { const int c = col0 + bj * HALF; const float ra = rstd[m] * alpha;
                    const f32x4 g0 = *(const f32x4*)(g + c) * ra, g1 = *(const f32x4*)(g + c + 4) * ra, b0 = *(const f32x4*)(b + c) * alpha, b1 = *(const f32x4*)(b + c + 4) * alpha;
                    const i32x4 a0 = acc[ai][bj][m][0], a1 = acc[ai][bj][m][1];
                    f32x4 q0, q1; q0.x = (float)a0.x; q0.y = (float)a0.y; q0.z = (float)a0.z; q0.w = (float)a0.w; q1.x = (float)a1.x; q1.y = (float)a1.y; q1.z = (float)a1.z; q1.w = (float)a1.w;
                    *(u32x4*)(rowp + bj * HALF) = pk8h((h4lo(y[m][bj]) - mean[m]) * g0 + b0 + q0 * f[m], (h4hi(y[m][bj]) - mean[m]) * g1 + b1 + q1 * f[m]); } }
            asm volatile("" ::: "memory");
        }
    }
};
struct EpiProjV {
    static constexpr bool PERM = true, AFTER_DRAIN = false;
    bf16_t* O; const float* rope; const float* rowinv; const float* cmax;
    __device__ __forceinline__ void operator()(const i32x4 (&acc)[2][2][4][2], const Unit& u, int wr, int wc, int fr, int fq) const {
        const int pn = u.pn < 16 ? u.pn : u.pn + 8;
        const int row0 = u.pm * BM + wr * 64 + fr, col0 = pn * BM + wc * 32 + 8 * fq;
        const bool rot = (pn >= 24) && (pn < 40);
        const float ksc = (pn >= 32 && pn < 40) ? 0.0625f : 1.0f;
        f32x4 cs[2][2];
#pragma unroll
        for (int bj = 0; bj < 2; ++bj)
#pragma unroll
            for (int n = 0; n < 2; ++n) cs[bj][n] = *(const f32x4*)(cmax + col0 + bj * HALF + 4 * n) * (1.0f / 127.0f);
#pragma unroll
        for (int ai = 0; ai < 2; ++ai)
#pragma unroll
            for (int m = 0; m < 4; ++m) {
                const int row = row0 + ai * HALF + m * 16;
                const float rf = rowinv[row];
                bf16_t* rowp = O + (size_t)row * 14336 + col0;
                f32x4 q[2][2];
#pragma unroll
                for (int bj = 0; bj < 2; ++bj)
#pragma unroll
                    for (int n = 0; n < 2; ++n) { const i32x4 a = acc[ai][bj][m][n]; f32x4 t; t.x = (float)a.x; t.y = (float)a.y; t.z = (float)a.z; t.w = (float)a.w; q[bj][n] = t * rf * cs[bj][n]; }
                f32x4 a0 = q[0][0], a1 = q[0][1], b0 = q[1][0], b1 = q[1][1];
                if (rot) {
                    const int pos = row < 16384 ? (row & 2047) : (row - 16384);
                    const f32x4* rp = (const f32x4*)(rope + ((size_t)pos * 128 + wc * 32 + 8 * fq) * 2);
                    const f32x4 r0 = rp[0], r1 = rp[1], r2 = rp[2], r3 = rp[3];
                    const f32x4 c0 = {r0.x, r0.z, r1.x, r1.z}, s0 = {r0.y, r0.w, r1.y, r1.w}, c1 = {r2.x, r2.z, r3.x, r3.z}, s1 = {r2.y, r2.w, r3.y, r3.w};
                    const f32x4 na0 = a0 * c0 - b0 * s0, nb0 = a0 * s0 + b0 * c0, na1 = a1 * c1 - b1 * s1, nb1 = a1 * s1 + b1 * c1;
                    a0 = na0 * ksc; b0 = nb0 * ksc; a1 = na1 * ksc; b1 = nb1 * ksc;
                }
                *(u32x4*)(rowp) = pk8(a0, a1); *(u32x4*)(rowp + HALF) = pk8(b0, b1);
            }
    }
};
}

constexpr int NWAVES = 8, NT = 512;
#ifndef MK_N_LAUNCHES
#define MK_N_LAUNCHES 1
#endif
constexpr int DM = 4096, MTOK = 24576, NIN = 14336, DFF = 11008, NFF2 = 22016;
constexpr int C_AQ = 0, C_AK = 1024, C_AV = 2048, C_HY = 3072, C_RQ = 6144, C_RK = 8192, C_RV = 10240, C_RG = 12288;
constexpr float ALPHA = 1.4142135623730951f;
constexpr int NPH = 10;
constexpr int N_PHASES = 2 + 2 * NPH;
constexpr size_t MiB = 1u << 20;
constexpr size_t WS_CTL = 0, CTL_ZERO_BYTES = 1 * MiB;
constexpr size_t WS_ROPE = 1 * MiB;
constexpr size_t WS_H2 = 9 * MiB;
constexpr size_t WS_ROWINV = 14 * MiB;
constexpr size_t WS_TW = 15 * MiB;
constexpr size_t WS_ROWINV2 = 14 * MiB + 131072;
constexpr size_t WS_FMTAB = 15 * MiB + 262144;
constexpr size_t WS_STATS = 14 * MiB + 262144;
constexpr size_t WS_FSTAB = 15 * MiB + 524288;
constexpr size_t WS_XB = 16 * MiB;
constexpr size_t WS_WIN = 208 * MiB;
constexpr size_t WS_WOUT = 320 * MiB;
constexpr size_t WS_WFI = 352 * MiB;
constexpr size_t WS_WFO = 524 * MiB;
constexpr size_t WS_FILT = 610 * MiB;
constexpr size_t WS_PROJ = 770 * MiB;
constexpr size_t WS_MIXED = 1442 * MiB;
constexpr size_t WS_HYT = 1634 * MiB;
constexpr size_t WS_ST = 1922 * MiB;
constexpr size_t WS_HQ = WS_MIXED;
constexpr size_t WS_ZOUT = 2306 * MiB;
constexpr size_t WS_FS = 2402 * MiB;
constexpr size_t WS_XR = 2410 * MiB;
constexpr size_t WS_XQ = 2602 * MiB;
constexpr size_t WS_WINQ = 2698 * MiB;
constexpr size_t WS_ROWINV3 = 14 * MiB + 524288;
constexpr size_t WS_END = 2746 * MiB;
constexpr int NB16 = 8 * 256, NQN = 48 * 256;
__device__ __forceinline__ int row_perm(int m) { const int j = m >> 11, r = m & 2047; return (11 - 3 * (j & 3) - (j >> 2)) * 2048 + r; }

constexpr size_t FILT_L1_OFF = (size_t)2 * 1024 * 4096;
constexpr int CW_BAR = 4096;
constexpr int CW_CMAX = 32768;
constexpr int CW_WMAX = 2048;
constexpr int LDS_BYTES = 151552;
constexpr int MISC_OFF = 147456;

#define GAS __attribute__((address_space(1)))
#define LAS __attribute__((address_space(3)))
typedef unsigned short bf16;
typedef unsigned v4u __attribute__((ext_vector_type(4)));
typedef unsigned v2u __attribute__((ext_vector_type(2)));
typedef float f32x4 __attribute__((ext_vector_type(4)));
typedef float f32x2 __attribute__((ext_vector_type(2)));
typedef short bf16x8 __attribute__((ext_vector_type(8)));
typedef short s16x4 __attribute__((ext_vector_type(4)));
__device__ __forceinline__ unsigned f2bf(float f) { unsigned u = __builtin_bit_cast(unsigned, f); return (u + 0x7fffu + ((u >> 16) & 1u)) >> 16; }
typedef __bf16 bf16x2_t __attribute__((ext_vector_type(2)));
__device__ __forceinline__ unsigned pk2(float lo, float hi) { const f32x2 v = {lo, hi}; return __builtin_bit_cast(unsigned, __builtin_convertvector(v, bf16x2_t)); }
__device__ __forceinline__ float bflo(unsigned w) { return __builtin_bit_cast(float, w << 16); }
__device__ __forceinline__ float bfhi(unsigned w) { return __builtin_bit_cast(float, w & 0xffff0000u); }
__device__ __forceinline__ s16x4 tr16(const LAS unsigned char* p) { return __builtin_bit_cast(s16x4, __builtin_amdgcn_ds_read_tr16_b64_v4i16((LAS s16x4*)p)); }
__device__ __forceinline__ bf16x8 cat8(s16x4 lo, s16x4 hi) { return __builtin_shufflevector(lo, hi, 0, 1, 2, 3, 4, 5, 6, 7); }
__device__ __forceinline__ f32x4 mfma16(bf16x8 a, bf16x8 b, f32x4 c) { return __builtin_amdgcn_mfma_f32_16x16x32_bf16(a, b, c, 0, 0, 0); }
#define LDS_WAIT() asm volatile("s_waitcnt lgkmcnt(0)" ::: "memory")
__device__ __forceinline__ float wave_sum(float v) {
#pragma unroll
    for (int o = 1; o < 64; o <<= 1) v += __shfl_xor(v, o);
    return v;
}
#define XB_TMO      128
#define XB_XCNT(j)  (256  + 64 * (j))
#define XB_XSUB(j)  (1280 + 64 * (j))
#define XB_XGEN(j)  (2304 + 64 * (j))
#define XB_TOP      3328
#define XB_TOPGEN   3392
#define XCD_BAR_WORDS 3456
#define XB_SPIN_CAP (1u << 18)

__device__ __forceinline__ unsigned xb_ld(unsigned* p)              { return __hip_atomic_load(p, __ATOMIC_RELAXED, __HIP_MEMORY_SCOPE_AGENT); }
__device__ __forceinline__ unsigned xb_add(unsigned* p, unsigned v) { return __hip_atomic_fetch_add(p, v, __ATOMIC_RELAXED, __HIP_MEMORY_SCOPE_AGENT); }
__device__ __forceinline__ unsigned xb_xcc_id() { return (unsigned)__builtin_amdgcn_s_getreg((3 << 11) | 20) & 0xFu; }
#define XB_SPIN(cond, bar) do { unsigned _sp = 0; while (cond) { __builtin_amdgcn_s_sleep(1); \
    if ((++_sp & 255u) == 0u) { if (xb_ld(&(bar)[XB_TMO])) break; if (_sp > XB_SPIN_CAP) { atomicAdd(&(bar)[XB_TMO], 1u); break; } } } } while (0)

struct XcdBarrier {
    unsigned* bar; unsigned x;
    volatile LAS unsigned* st;
};

__device__ __forceinline__ XcdBarrier xcd_barrier_post(unsigned* bar, volatile LAS unsigned* st) {
    XcdBarrier b; b.bar = bar; b.x = xb_xcc_id(); b.st = st;
    if (threadIdx.x == 0) (void)xb_add(&bar[XB_XCNT(b.x)], 1u);
    return b;
}
__device__ __forceinline__ void xcd_barrier_complete(unsigned* bar, unsigned x, unsigned& nloc, unsigned& nx) {
    const unsigned G = gridDim.x * gridDim.y * gridDim.z;
    unsigned sum, cnt, mine, sp = 0u;
    for (;;) {
        sum = 0u; cnt = 0u; mine = 0u;
#pragma unroll
        for (unsigned j = 0; j < 16; ++j) { const unsigned c = xb_ld(&bar[XB_XCNT(j)]); sum += c; cnt += (c > 0u) ? 1u : 0u; mine = (j == x) ? c : mine; }
        if (sum == G) break;
        __builtin_amdgcn_s_sleep(1);
        if ((++sp & 255u) == 0u) { if (xb_ld(&bar[XB_TMO])) break; if (sp > XB_SPIN_CAP) { atomicAdd(&bar[XB_TMO], 1u); break; } }
    }
    nloc = mine > 0u ? mine : 1u; nx = cnt > 0u ? cnt : 1u;
}

__device__ __forceinline__ void xcd_barrier(const XcdBarrier& b) {
    asm volatile("s_waitcnt vmcnt(0)" ::: "memory");
    __syncthreads();
    if (threadIdx.x == 0) {
        unsigned* bar = b.bar;
        __builtin_amdgcn_s_waitcnt(0);
        unsigned nloc = b.st[0], nx = b.st[1];
        if (nloc == 0u) { xcd_barrier_complete(bar, b.x, nloc, nx); b.st[0] = nloc; b.st[1] = nx; }
        const unsigned old = xb_add(&bar[XB_XSUB(b.x)], 1u);
        const unsigned gen = old / nloc;
        if (old + 1u == (gen + 1u) * nloc) {
            __builtin_amdgcn_fence(__ATOMIC_RELEASE, "agent");
            asm volatile("s_waitcnt vmcnt(0)" ::: "memory");
            const unsigned og = xb_add(&bar[XB_TOP], 1u);
            const unsigned tg = og / nx;
            if (og + 1u == (tg + 1u) * nx) xb_add(&bar[XB_TOPGEN], 1u);
            else XB_SPIN(xb_ld(&bar[XB_TOPGEN]) == tg, bar);
            __builtin_amdgcn_fence(__ATOMIC_ACQUIRE, "agent");
            xb_add(&bar[XB_XGEN(b.x)], 1u);
            asm volatile("s_waitcnt vmcnt(0)" ::: "memory");
        } else {
            XB_SPIN(xb_ld(&bar[XB_XGEN(b.x)]) == gen, bar);
            __builtin_amdgcn_fence(__ATOMIC_ACQUIRE, "agent");
            asm volatile("s_waitcnt vmcnt(0)" ::: "memory");
        }
    }
    __syncthreads();
}

__device__ __forceinline__ void transpose_item(const float* W, int K, int N, bf16* WT, int k0, int n0, int drow0, LAS float* scr, int lane) {
#pragma unroll 16
    for (int i = 0; i < 32; ++i) { const int kk = 2 * i + (lane >> 5); scr[kk * 33 + (lane & 31)] = __builtin_nontemporal_load(W + (size_t)(k0 + kk) * N + n0 + (lane & 31)); }
    LDS_WAIT();
    const int c = lane & 7;
#pragma unroll
    for (int j = 0; j < 4; ++j) { const int n = (lane >> 3) + 8 * j; const LAS float* s = scr + (8 * c) * 33 + n;
        v4u o; o.x = pk2(s[0 * 33], s[1 * 33]); o.y = pk2(s[2 * 33], s[3 * 33]); o.z = pk2(s[4 * 33], s[5 * 33]); o.w = pk2(s[6 * 33], s[7 * 33]);
        *(v4u*)(WT + (size_t)(drow0 + n) * K + k0 + 8 * c) = o; }
    LDS_WAIT();
}
__device__ __forceinline__ void transpose_item_h(const float* W, int K, int N, bf16* WT, int k0, int n0, int drow0, LAS float* scr, int lane) {
#pragma unroll 16
    for (int i = 0; i < 32; ++i) { const int kk = 2 * i + (lane >> 5); scr[kk * 33 + (lane & 31)] = __builtin_nontemporal_load(W + (size_t)(k0 + kk) * N + n0 + (lane & 31)); }
    LDS_WAIT();
    const int c = lane & 7;
#pragma unroll
    for (int j = 0; j < 4; ++j) { const int n = (lane >> 3) + 8 * j; const LAS float* s = scr + (8 * c) * 33 + n;
        v4u o; o.x = pg8::pkh(s[0 * 33], s[1 * 33]); o.y = pg8::pkh(s[2 * 33], s[3 * 33]); o.z = pg8::pkh(s[4 * 33], s[5 * 33]); o.w = pg8::pkh(s[6 * 33], s[7 * 33]);
        *(v4u*)(WT + (size_t)(drow0 + n) * K + k0 + 8 * c) = o; }
    LDS_WAIT();
}
__device__ __forceinline__ void transpose_item_q(const float* W, int K, int N, signed char* WT, int k0, int n0, int drow0, float sw, LAS float* scr, int lane) {
#pragma unroll 16
    for (int i = 0; i < 32; ++i) { const int kk = 2 * i + (lane >> 5); scr[kk * 33 + (lane & 31)] = __builtin_nontemporal_load(W + (size_t)(k0 + kk) * N + n0 + (lane & 31)); }
    LDS_WAIT();
    const int n = lane >> 1, hf = lane & 1; const LAS float* s = scr + (hf * 32) * 33 + n;
    unsigned o[8];
#pragma unroll
    for (int d = 0; d < 8; ++d) { unsigned w = 0;
#pragma unroll
        for (int b = 0; b < 4; ++b) { const float q = fminf(fmaxf(rintf(s[(4 * d + b) * 33] * sw), -127.f), 127.f); w |= ((unsigned)(int)q & 0xffu) << (8 * b); }
        o[d] = w; }
    v4u* dst = (v4u*)(WT + (size_t)(drow0 + n) * K + k0 + hf * 32);
    dst[0] = (v4u){o[0], o[1], o[2], o[3]}; dst[1] = (v4u){o[4], o[5], o[6], o[7]};
    LDS_WAIT();
}
__device__ __forceinline__ void transpose_item_qc(const float* W, int K, int N, signed char* WT, int k0, int n0, int drow0, const unsigned* colmax_bits, LAS float* scr, int lane) {
#pragma unroll 16
    for (int i = 0; i < 32; ++i) { const int kk = 2 * i + (lane >> 5); scr[kk * 33 + (lane & 31)] = __builtin_nontemporal_load(W + (size_t)(k0 + kk) * N + n0 + (lane & 31)); }
    LDS_WAIT();
    const int n = lane >> 1, hf = lane & 1; const LAS float* s = scr + (hf * 32) * 33 + n;
    const float sw = 127.0f / fmaxf(__builtin_bit_cast(float, colmax_bits[n0 + n]), 1e-30f);
    unsigned o[8];
#pragma unroll
    for (int dd = 0; dd < 8; ++dd) { unsigned w = 0;
#pragma unroll
        for (int b = 0; b < 4; ++b) { const float q = fminf(fmaxf(rintf(s[(4 * dd + b) * 33] * sw), -127.f), 127.f); w |= ((unsigned)(int)q & 0xffu) << (8 * b); }
        o[dd] = w; }
    v4u* dst = (v4u*)(WT + (size_t)(drow0 + n) * K + k0 + hf * 32);
    dst[0] = (v4u){o[0], o[1], o[2], o[3]}; dst[1] = (v4u){o[4], o[5], o[6], o[7]};
    LDS_WAIT();
}
__device__ __forceinline__ void colmax_f32(const float* W, int K, int ld, int ncols, unsigned* dst, int gw, int ngw, int lane) {
    const int nb = ncols / 256;
    for (int it = gw; it < (K / 64) * nb; it += ngw) { const int kb = it / nb, cb = it % nb; const float* p = W + (size_t)(kb * 64) * ld + cb * 256 + lane * 4; f32x4 m = {0.f, 0.f, 0.f, 0.f};
#pragma unroll 16
        for (int k = 0; k < 64; ++k) { const f32x4 v = __builtin_nontemporal_load((const f32x4*)(p + (size_t)k * ld)); m.x = fmaxf(m.x, fabsf(v.x)); m.y = fmaxf(m.y, fabsf(v.y)); m.z = fmaxf(m.z, fabsf(v.z)); m.w = fmaxf(m.w, fabsf(v.w)); }
        unsigned* d = dst + cb * 256 + lane * 4;
        atomicMax(d, __builtin_bit_cast(unsigned, m.x + 0.f)); atomicMax(d + 1, __builtin_bit_cast(unsigned, m.y + 0.f)); atomicMax(d + 2, __builtin_bit_cast(unsigned, m.z + 0.f)); atomicMax(d + 3, __builtin_bit_cast(unsigned, m.w + 0.f)); }
}
__device__ __forceinline__ void absmax_f32(const float* w, size_t n4, unsigned* dst, size_t gtid, size_t nthr, int lane) {
    float m = 0.f;
    size_t i = gtid;
    for (; i + 7 * nthr < n4; i += 8 * nthr) { f32x4 v[8];
#pragma unroll
        for (int j = 0; j < 8; ++j) v[j] = __builtin_nontemporal_load((const f32x4*)w + i + j * nthr);
#pragma unroll
        for (int j = 0; j < 8; ++j) m = fmaxf(fmaxf(m, fmaxf(fabsf(v[j].x), fabsf(v[j].y))), fmaxf(fabsf(v[j].z), fabsf(v[j].w))); }
    for (; i < n4; i += nthr) { const f32x4 v = ((const f32x4*)w)[i]; m = fmaxf(fmaxf(m, fmaxf(fabsf(v.x), fabsf(v.y))), fmaxf(fabsf(v.z), fabsf(v.w))); }
#pragma unroll
    for (int o = 1; o < 64; o <<= 1) m = fmaxf(m, __shfl_xor(m, o));
    if (lane == 0) atomicMax(dst, __builtin_bit_cast(unsigned, m));
}
__device__ __forceinline__ void ln_row_q(const float* src, const float* g, const float* b, signed char* dstq, float* rowinv, float* stat, int lane) {
    const f32x4* xr = (const f32x4*)src + lane;
    f32x4 v[16]; float s = 0.f;
#pragma unroll
    for (int j = 0; j < 16; ++j) { v[j] = xr[64 * j]; s += (v[j].x + v[j].y) + (v[j].z + v[j].w); }
    const float mean = wave_sum(s) * (1.f / 4096.f); float s2 = 0.f;
#pragma unroll
    for (int j = 0; j < 16; ++j) { v[j] = v[j] - mean; s2 += (v[j].x * v[j].x + v[j].y * v[j].y) + (v[j].z * v[j].z + v[j].w * v[j].w); }
    const float rstd = 1.f / sqrtf(wave_sum(s2) * (1.f / 4096.f) + 1e-5f);
    if (lane == 0) { stat[0] = mean; stat[1] = rstd; }
    float mx = 0.f;
#pragma unroll
    for (int j = 0; j < 16; ++j) {
        const f32x4 gg = ((const f32x4*)g)[64 * j + lane], bb = ((const f32x4*)b)[64 * j + lane];
        v[j] = v[j] * rstd * gg + bb;
        mx = fmaxf(fmaxf(mx, fmaxf(fabsf(v[j].x), fabsf(v[j].y))), fmaxf(fabsf(v[j].z), fabsf(v[j].w)));
    }
#pragma unroll
    for (int o = 1; o < 64; o <<= 1) mx = fmaxf(mx, __shfl_xor(mx, o));
    mx = fmaxf(mx, 1e-20f);
    const float sc = 127.0f / mx;
    if (lane == 0) *rowinv = mx * (1.0f / 127.0f);
#pragma unroll
    for (int j = 0; j < 16; ++j) {
        const unsigned w = ((unsigned)(int)rintf(v[j].x * sc) & 0xffu) | (((unsigned)(int)rintf(v[j].y * sc) & 0xffu) << 8) | (((unsigned)(int)rintf(v[j].z * sc) & 0xffu) << 16) | (((unsigned)(int)rintf(v[j].w * sc) & 0xffu) << 24);
        ((unsigned*)dstq)[64 * j + lane] = w;
    }
}
__device__ __forceinline__ void ln_load_b(const bf16* src, f32x4 (&v)[16], float& mean, float& rstd, int lane) {
    const v4u* xr = (const v4u*)src + lane; float s = 0.f;
#pragma unroll
    for (int j = 0; j < 8; ++j) { const v4u w = xr[64 * j]; v[2 * j] = pg8::h4lo(w); v[2 * j + 1] = pg8::h4hi(w);
        s += ((v[2 * j].x + v[2 * j].y) + (v[2 * j].z + v[2 * j].w)) + ((v[2 * j + 1].x + v[2 * j + 1].y) + (v[2 * j + 1].z + v[2 * j + 1].w)); }
    mean = wave_sum(s) * (1.f / 4096.f); float s2 = 0.f;
#pragma unroll
    for (int j = 0; j < 16; ++j) { v[j] = v[j] - mean; s2 += (v[j].x * v[j].x + v[j].y * v[j].y) + (v[j].z * v[j].z + v[j].w * v[j].w); }
    rstd = 1.f / sqrtf(wave_sum(s2) * (1.f / 4096.f) + 1e-5f);
}
__device__ __forceinline__ void ln_row_qb(const bf16* src, const float* g, const float* b, signed char* dstq, float* rowinv, float* stat, int lane) {
    f32x4 v[16]; float mean, rstd; ln_load_b(src, v, mean, rstd, lane);
    if (lane == 0) { stat[0] = mean; stat[1] = rstd; }
    float mx = 0.f;
#pragma unroll
    for (int j = 0; j < 16; ++j) {
        const int q = 2 * (64 * (j >> 1) + lane) + (j & 1);
        const f32x4 gg = ((const f32x4*)g)[q], bb = ((const f32x4*)b)[q];
        v[j] = v[j] * rstd * gg + bb;
        mx = fmaxf(fmaxf(mx, fmaxf(fabsf(v[j].x), fabsf(v[j].y))), fmaxf(fabsf(v[j].z), fabsf(v[j].w)));
    }
#pragma unroll
    for (int o = 1; o < 64; o <<= 1) mx = fmaxf(mx, __shfl_xor(mx, o));
    mx = fmaxf(mx, 1e-20f);
    const float sc = 127.0f / mx;
    if (lane == 0) *rowinv = mx * (1.0f / 127.0f);
#pragma unroll
    for (int j = 0; j < 8; ++j) { v2u w;
        w.x = ((unsigned)(int)rintf(v[2 * j].x * sc) & 0xffu) | (((unsigned)(int)rintf(v[2 * j].y * sc) & 0xffu) << 8) | (((unsigned)(int)rintf(v[2 * j].z * sc) & 0xffu) << 16) | (((unsigned)(int)rintf(v[2 * j].w * sc) & 0xffu) << 24);
        w.y = ((unsigned)(int)rintf(v[2 * j + 1].x * sc) & 0xffu) | (((unsigned)(int)rintf(v[2 * j + 1].y * sc) & 0xffu) << 8) | (((unsigned)(int)rintf(v[2 * j + 1].z * sc) & 0xffu) << 16) | (((unsigned)(int)rintf(v[2 * j + 1].w * sc) & 0xffu) << 24);
        ((v2u*)dstq)[64 * j + lane] = w; }
}
template <bool WF> __device__ __forceinline__ void ln_row_b(const bf16* src, const float* g, const float* b, float* dstf, bf16* dstb, int lane) {
    f32x4 v[16]; float mean, rstd; ln_load_b(src, v, mean, rstd, lane);
#pragma unroll
    for (int j = 0; j < 8; ++j) { const int q = 2 * (64 * j + lane);
        const f32x4 o0 = v[2 * j] * rstd * ((const f32x4*)g)[q] + ((const f32x4*)b)[q], o1 = v[2 * j + 1] * rstd * ((const f32x4*)g)[q + 1] + ((const f32x4*)b)[q + 1];
        if (WF) { ((f32x4*)dstf)[q] = o0; ((f32x4*)dstf)[q + 1] = o1; }
        else { v4u w; w.x = pk2(o0.x, o0.y); w.y = pk2(o0.z, o0.w); w.z = pk2(o1.x, o1.y); w.w = pk2(o1.z, o1.w); ((v4u*)dstb)[64 * j + lane] = w; } }
}
__device__ __forceinline__ void quant_row_h(const bf16* src, signed char* dst, float* rowinv, int lane) {
    v4u x[22]; float mx = 0.f;
#pragma unroll
    for (int i = 0; i < 22; ++i) { const int id = lane + 64 * i; x[i] = id < 1376 ? __builtin_nontemporal_load((const v4u*)src + id) : (v4u){0u, 0u, 0u, 0u};
        mx = fmaxf(mx, fmaxf(fmaxf(fmaxf(fabsf(bflo(x[i].x)), fabsf(bfhi(x[i].x))), fmaxf(fabsf(bflo(x[i].y)), fabsf(bfhi(x[i].y)))), fmaxf(fmaxf(fabsf(bflo(x[i].z)), fabsf(bfhi(x[i].z))), fmaxf(fabsf(bflo(x[i].w)), fabsf(bfhi(x[i].w)))))); }
#pragma unroll
    for (int o = 1; o < 64; o <<= 1) mx = fmaxf(mx, __shfl_xor(mx, o));
    mx = fmaxf(mx, 1e-20f);
    const float sc = 127.0f / mx;
    if (lane == 0) *rowinv = mx * (1.0f / 127.0f);
#pragma unroll
    for (int i = 0; i < 22; ++i) { const int id = lane + 64 * i;
        if (id < 1376) { v2u w;
            w.x = ((unsigned)(int)rintf(bflo(x[i].x) * sc) & 0xffu) | (((unsigned)(int)rintf(bfhi(x[i].x) * sc) & 0xffu) << 8) | (((unsigned)(int)rintf(bflo(x[i].y) * sc) & 0xffu) << 16) | (((unsigned)(int)rintf(bfhi(x[i].y) * sc) & 0xffu) << 24);
            w.y = ((unsigned)(int)rintf(bflo(x[i].z) * sc) & 0xffu) | (((unsigned)(int)rintf(bfhi(x[i].z) * sc) & 0xffu) << 8) | (((unsigned)(int)rintf(bflo(x[i].w) * sc) & 0xffu) << 16) | (((unsigned)(int)rintf(bfhi(x[i].w) * sc) & 0xffu) << 24);
            ((v2u*)dst)[id] = w; } }
}
__device__ __forceinline__ void convert_weights(const float* w_in, const float* w_out, const float* w_fi, const float* w_fo, unsigned char* ws, const unsigned* wmax_bits, const unsigned* cmax_bits, LAS unsigned char* lds, int gw, int ngw, int wave, int lane) {
    const float sw = 127.0f / fmaxf(__builtin_bit_cast(float, wmax_bits[0]), 1e-30f), sw2 = 127.0f / fmaxf(__builtin_bit_cast(float, wmax_bits[2]), 1e-30f);
    LAS float* scr = (LAS float*)(lds + wave * 8704);
    constexpr int I_IN = 64 * 448, I_OUT = 64 * 128, I_FI = 64 * 688, I_FO = 172 * 128;
    for (int it = gw; it < I_IN + I_OUT + I_FI + I_FO; it += ngw) {
        int r = it;
        if (r < I_IN) { const int kb = r / 448, nb = r % 448;
            const int n0 = nb * 32, pn = n0 >> 8, nin = n0 & 255;
            if (pn < 16 || pn >= 24) transpose_item_qc(w_in, 4096, NIN, (signed char*)(ws + WS_WINQ), kb * 64, n0, (pn < 16 ? pn : pn - 8) * 256 + nin, cmax_bits, scr, lane);
            else transpose_item_h(w_in, 4096, NIN, (bf16*)(ws + WS_WIN), kb * 64, n0, (pn - 16) * 256 + nin, scr, lane);
            continue; } r -= I_IN;
        if (r < I_OUT) { const int kb = r / 128, nb = r % 128; transpose_item(w_out, 4096, 4096, (bf16*)(ws + WS_WOUT), kb * 64, nb * 32, nb * 32, scr, lane); continue; } r -= I_OUT;
        if (r < I_FI) { const int kb = r / 688, nb = r % 688, n0 = nb * 32, bj = n0 >= DFF ? 1 : 0, rem = n0 - bj * DFF;
            transpose_item_q(w_fi, 4096, NFF2, (signed char*)(ws + WS_WFI), kb * 64, n0, 256 * (rem >> 7) + 128 * bj + (rem & 127), sw, scr, lane); continue; } r -= I_FI;
        { const int kb = r / 128, nb = r % 128; transpose_item_q(w_fo, DFF, 4096, (signed char*)(ws + WS_WFO), kb * 64, nb * 32, nb * 32, sw2, scr, lane); }
    }
}
template <bool WF> __device__ __forceinline__ void ln_row(const float* src, const float* g, const float* b, float* dstf, bf16* dstb, float* stat, int lane) {
    const f32x4* xr = (const f32x4*)src + lane;
    f32x4 v[16]; float s = 0.f;
#pragma unroll
    for (int j = 0; j < 16; ++j) { v[j] = xr[64 * j]; s += (v[j].x + v[j].y) + (v[j].z + v[j].w); }
    const float mean = wave_sum(s) * (1.f / 4096.f); float s2 = 0.f;
#pragma unroll
    for (int j = 0; j < 16; ++j) { v[j] = v[j] - mean; s2 += (v[j].x * v[j].x + v[j].y * v[j].y) + (v[j].z * v[j].z + v[j].w * v[j].w); }
    const float rstd = 1.f / sqrtf(wave_sum(s2) * (1.f / 4096.f) + 1e-5f);
    if (!WF && lane == 0) { stat[0] = mean; stat[1] = rstd; }
#pragma unroll
    for (int j = 0; j < 16; ++j) {
        const f32x4 gg = ((const f32x4*)g)[64 * j + lane], bb = ((const f32x4*)b)[64 * j + lane];
        const f32x4 o = v[j] * rstd * gg + bb;
        if (WF) ((f32x4*)dstf)[64 * j + lane] = o;
        if (dstb) { v2u w; w.x = pk2(o.x, o.y); w.y = pk2(o.z, o.w); ((v2u*)dstb)[64 * j + lane] = w; }
    }
}
template <bool PAIR> __device__ __forceinline__ void row_quant(const f32x4 (&v)[16], signed char* dstq, float* rowinv, int lane) {
    float mx = 0.f;
#pragma unroll
    for (int j = 0; j < 16; ++j) mx = fmaxf(fmaxf(mx, fmaxf(fabsf(v[j].x), fabsf(v[j].y))), fmaxf(fabsf(v[j].z), fabsf(v[j].w)));
#pragma unroll
    for (int o = 1; o < 64; o <<= 1) mx = fmaxf(mx, __shfl_xor(mx, o));
    mx = fmaxf(mx, 1e-20f);
    const float sc = 127.0f / mx;
    if (lane == 0) *rowinv = mx * (1.0f / 127.0f);
    unsigned w[16];
#pragma unroll
    for (int j = 0; j < 16; ++j) w[j] = ((unsigned)(int)rintf(v[j].x * sc) & 0xffu) | (((unsigned)(int)rintf(v[j].y * sc) & 0xffu) << 8) | (((unsigned)(int)rintf(v[j].z * sc) & 0xffu) << 16) | (((unsigned)(int)rintf(v[j].w * sc) & 0xffu) << 24);
    if (PAIR) {
#pragma unroll
        for (int j = 0; j < 8; ++j) ((v2u*)dstq)[64 * j + lane] = (v2u){w[2 * j], w[2 * j + 1]};
    } else {
#pragma unroll
        for (int j = 0; j < 16; ++j) ((unsigned*)dstq)[64 * j + lane] = w[j];
    }
}
__device__ __forceinline__ void ln_row_in(const float* src, const float* g, const float* b, bf16* dstb, signed char* dstq, float* rowinv, int lane) {
    const f32x4* xr = (const f32x4*)src + lane;
    f32x4 v[16]; float s = 0.f;
#pragma unroll
    for (int j = 0; j < 16; ++j) { v[j] = __builtin_nontemporal_load(xr + 64 * j); s += (v[j].x + v[j].y) + (v[j].z + v[j].w); }
    const float mean = wave_sum(s) * (1.f / 4096.f); float s2 = 0.f;
#pragma unroll
    for (int j = 0; j < 16; ++j) { v[j] = v[j] - mean; s2 += (v[j].x * v[j].x + v[j].y * v[j].y) + (v[j].z * v[j].z + v[j].w * v[j].w); }
    const float rstd = 1.f / sqrtf(wave_sum(s2) * (1.f / 4096.f) + 1e-5f);
#pragma unroll
    for (int j = 0; j < 16; ++j) {
        const f32x4 gg = ((const f32x4*)g)[64 * j + lane], bb = ((const f32x4*)b)[64 * j + lane];
        v[j] = v[j] * rstd * gg + bb;
        v2u w; w.x = pg8::pkh(v[j].x, v[j].y); w.y = pg8::pkh(v[j].z, v[j].w); ((v2u*)dstb)[64 * j + lane] = w;
    }
    row_quant<false>(v, dstq, rowinv, lane);
}
__device__ __forceinline__ void ln_row_b_in(const bf16* src, const float* g, const float* b, bf16* dstb, signed char* dstq, float* rowinv, int lane) {
    f32x4 v[16]; float mean, rstd; ln_load_b(src, v, mean, rstd, lane);
#pragma unroll
    for (int j = 0; j < 8; ++j) { const int q = 2 * (64 * j + lane);
        v[2 * j] = v[2 * j] * rstd * ((const f32x4*)g)[q] + ((const f32x4*)b)[q]; v[2 * j + 1] = v[2 * j + 1] * rstd * ((const f32x4*)g)[q + 1] + ((const f32x4*)b)[q + 1];
        v4u w; w.x = pg8::pkh(v[2 * j].x, v[2 * j].y); w.y = pg8::pkh(v[2 * j].z, v[2 * j].w); w.z = pg8::pkh(v[2 * j + 1].x, v[2 * j + 1].y); w.w = pg8::pkh(v[2 * j + 1].z, v[2 * j + 1].w); ((v4u*)dstb)[64 * j + lane] = w; }
    row_quant<true>(v, dstq, rowinv, lane);
}
__device__ __forceinline__ void pre_tables(const float* w1a, const float* b1a, const float* fqa, const float* w2a, const float* b2a, unsigned char* ws, int gw, int ngw, int lane) {
    float* rope = (float*)(ws + WS_ROPE);
    for (int i = gw * 64 + lane; i < 8192 * 128; i += ngw * 64) {
        const int pos = i >> 7, j = i & 127;
        const float inv = 1.0f / powf(10000.0f, (float)j * (1.0f / 127.0f));
        const float ang = (float)pos * inv;
        rope[2 * i] = cosf(ang); rope[2 * i + 1] = sinf(ang);
    }
    { float* tw = (float*)(ws + WS_TW);
      for (int j = gw * 64 + lane; j < 16384; j += ngw * 64) { float sn, cs; sincospif(-2.0f * (float)j / 16384.0f, &sn, &cs); tw[2 * j] = cs; tw[2 * j + 1] = sn; } }
    float* H2 = (float*)(ws + WS_H2);
    for (int it = gw; it < 2 * 10240; it += ngw) {
        const int l = it / 10240, r = it % 10240, Lidx = r >= 2048 ? 1 : 0, t = Lidx ? r - 2048 : r, L = Lidx ? 8192 : 2048;
        const float* w1 = w1a + l * 33 * 64; const float* b1 = b1a + l * 64; const float* fq = fqa + l * 128; const float* w2 = w2a + l * 64 * 64; const float* b2 = b2a + l * 64;
        float z = 0.f;
        if (lane == 0) z = (float)t / (float)(L - 1);
        else if (lane < 33) { const int i = (lane - 1) & 15; const float sfr = (float)i / 15.0f; const float fr = 1e-4f * (1.0f - sfr) + 15.0f * sfr;
            const float wpos = (6.283185307179586f * (float)t) / (float)L; const float a = fr * wpos; z = lane < 17 ? cosf(a) : -sinf(a); }
        float p1 = b1[lane];
        for (int e = 0; e < 33; ++e) p1 += __shfl(z, e) * w1[e * 64 + lane];
        const float h1 = sinf(fq[lane] * p1);
        float p2 = b2[lane];
        for (int j = 0; j < 64; ++j) p2 += __shfl(h1, j) * w2[j * 64 + lane];
        H2[(size_t)it * 64 + lane] = sinf(fq[64 + lane] * p2);
    }
}
__device__ __forceinline__ void filter_assembly(const float* w3, const float* b3, const float* skip, const float* H2l, float* FILT, LAS unsigned char* lds, int vb, int nb, int tid, int wave, int lane) {
    LAS float* Hs = (LAS float*)lds;
    LAS float* tile = (LAS float*)(lds + 8192 + wave * 8448);
    constexpr int U0 = 2 * 2 * 64, U1 = 2 * 2 * 256;
    for (int it = vb; it < U0 + U1; it += nb) {
        const int Lidx = it >= U0 ? 1 : 0, r = Lidx ? it - U0 : it, L = Lidx ? 8192 : 2048, ntt = L / 32;
        const int tt = r % ntt, dir = (r / ntt) & 1, o = r / (ntt * 2);
        __syncthreads();
        ((LAS f32x4*)Hs)[tid] = ((const f32x4*)(H2l + (size_t)((Lidx ? 2048 : 0) + tt * 32) * 64))[tid];
        __syncthreads();
#pragma unroll 1
        for (int ci = 0; ci < 2; ++ci) {
            const int cg = wave + 8 * ci;
            const int x = lane & 15, g = lane >> 4;
            float av[2][16];
#pragma unroll
            for (int t2 = 0; t2 < 2; ++t2)
#pragma unroll
                for (int kk = 0; kk < 16; ++kk) av[t2][kk] = Hs[(16 * t2 + x) * 64 + 4 * kk + g];
#pragma unroll 1
            for (int ct = 0; ct < 4; ++ct) {
                const int c = cg * 64 + ct * 16 + x, col = (o * 2 + dir) * 1024 + c;
                float bw[16];
#pragma unroll
                for (int kk = 0; kk < 16; ++kk) bw[kk] = w3[(4 * kk + g) * 4096 + col];
                const float bias = b3[col];
                const float delta = fabsf(-3.0701134573253945f + (float)c * ((-15.350567286626973f + 3.0701134573253945f) / 1023.0f));
                const float sk = skip[o * 1024 + c];
#pragma unroll
                for (int t2 = 0; t2 < 2; ++t2) {
                    f32x4 acc = {0.f, 0.f, 0.f, 0.f};
#pragma unroll
                    for (int kk = 0; kk < 16; ++kk) acc = __builtin_amdgcn_mfma_f32_16x16x4f32(av[t2][kk], bw[kk], acc, 0, 0, 0);
#pragma unroll
                    for (int e = 0; e < 4; ++e) { const int tl = 16 * t2 + 4 * g + e, t = tt * 32 + tl;
                        float a = (acc[e] + bias) * expf(-((float)t / (float)(L - 1)) * delta);
                        if (dir == 0 && t == 0) a += sk;
                        if (dir == 1 && t == 0) a = 0.f;
                        tile[(ct * 16 + x) * 33 + tl] = a; }
                }
            }
            LDS_WAIT();
            float* Fb = FILT + (Lidx ? FILT_L1_OFF : 0) + ((size_t)o * 1024 + cg * 64) * (size_t)(2 * L);
            const int t = tt * 32 + (lane & 31);
            const int p = dir == 0 ? t : (t == 0 ? L : 2 * L - t);
#pragma unroll 8
            for (int c2 = 0; c2 < 32; ++c2) { const int cc = 2 * c2 + (lane >> 5); Fb[(size_t)cc * (2 * L) + p] = tile[cc * 33 + (lane & 31)]; }
            LDS_WAIT();
        }
    }
    __syncthreads();
}
__device__ __forceinline__ void hyena_transpose(const bf16* proj, const float* cw, const float* cb, float* HYT, LAS unsigned char* lds, int gw, int ngw, int wave, int lane_in) {
    for (int it = gw; it < 3 * 16 * 384; it += ngw) {
        int lane = lane_in; asm volatile("" : "+v"(lane));
        const int tl = it % 384, cg = (it / 384) & 15, part = it / (384 * 16);
        const int R0 = tl * 64, sbeg = R0 < 16384 ? (R0 & ~2047) : 16384, send = R0 < 16384 ? sbeg + 2048 : 24576;
        const int t8 = lane >> 3, c8 = lane & 7, pc0 = part * 1024 + cg * 64 + c8 * 8;
        const bf16* src = proj + (size_t)(R0 + 8 * t8) * NIN + C_HY + pc0;
        v4u x[10];
#pragma unroll
        for (int i = 0; i < 8; ++i) x[1 + i] = *(const v4u*)(src + (size_t)i * NIN);
        v4u hlo = {0u, 0u, 0u, 0u}, hhi = {0u, 0u, 0u, 0u};
        if (t8 == 0 && R0 > sbeg) hlo = *(const v4u*)(src - (ptrdiff_t)NIN);
        if (t8 == 7 && R0 + 64 < send) hhi = *(const v4u*)(src + (size_t)8 * NIN);
        f32x4 w0[2], w1[2], w2[2], bb[2];
#pragma unroll
        for (int q = 0; q < 2; ++q) { w0[q] = *(const f32x4*)(cw + pc0 + 4 * q); w1[q] = *(const f32x4*)(cw + 3072 + pc0 + 4 * q); w2[q] = *(const f32x4*)(cw + 6144 + pc0 + 4 * q); bb[q] = *(const f32x4*)(cb + pc0 + 4 * q); }
        { v4u up, dn;
          up.x = __shfl(x[8].x, lane - 8); up.y = __shfl(x[8].y, lane - 8); up.z = __shfl(x[8].z, lane - 8); up.w = __shfl(x[8].w, lane - 8);
          dn.x = __shfl(x[1].x, lane + 8); dn.y = __shfl(x[1].y, lane + 8); dn.z = __shfl(x[1].z, lane + 8); dn.w = __shfl(x[1].w, lane + 8);
          x[0] = t8 == 0 ? hlo : up; x[9] = t8 == 7 ? hhi : dn; }
        float* dst = HYT + (size_t)pc0 * MTOK + R0 + 8 * t8;
#pragma unroll
        for (int k = 0; k < 8; ++k) {
            const float a0 = w0[k >> 2][k & 3], a1 = w1[k >> 2][k & 3], a2 = w2[k >> 2][k & 3], ab = bb[k >> 2][k & 3];
            float v[10];
#pragma unroll
            for (int i = 0; i < 10; ++i) { const unsigned d = (k >> 1) == 0 ? x[i].x : (k >> 1) == 1 ? x[i].y : (k >> 1) == 2 ? x[i].z : x[i].w; v[i] = (k & 1) ? bfhi(d) : bflo(d); }
            f32x4 o0, o1;
#pragma unroll
            for (int i = 0; i < 4; ++i) { o0[i] = a0 * v[i] + a1 * v[i + 1] + a2 * v[i + 2] + ab; o1[i] = a0 * v[i + 4] + a1 * v[i + 5] + a2 * v[i + 6] + ab; }
            *(f32x4*)(dst + (size_t)k * MTOK) = o0; *(f32x4*)(dst + (size_t)k * MTOK + 4) = o1;
        }
    }
}
__device__ __forceinline__ void hyena_norm(const float* ZT, const float* gain, bf16* mixed, LAS unsigned char* lds, int vb, int nb, int wave, int lane) {
    LAS float* tile = (LAS float*)(lds + wave * 16640);
    LAS float* ssx = (LAS float*)(lds + 8 * 16640);
    for (int tl = vb; tl < 384; tl += nb) {
        const int R0 = tl * 64;
        const float* src = ZT + (size_t)(wave * 128) * MTOK + R0 + lane;
        float ss = 0.f;
        for (int c = 0; c < 128; ++c) { const float v = src[(size_t)c * MTOK]; ss += v * v; }
        ssx[wave * 64 + lane] = ss;
        __syncthreads();
        float tot = 0.f;
#pragma unroll
        for (int w = 0; w < 8; ++w) tot += ssx[w * 64 + lane];
        const float rstd = 1.0f / sqrtf(tot * (1.0f / 1024.0f) + 1e-6f);
        for (int cb = 0; cb < 2; ++cb) {
            const int c0 = wave * 128 + cb * 64;
            for (int cc = 0; cc < 64; ++cc) tile[cc * 65 + lane] = src[(size_t)(cb * 64 + cc) * MTOK] * rstd;
            LDS_WAIT();
            const float gv = gain[c0 + lane];
            for (int i = 0; i < 64; ++i) mixed[(size_t)(R0 + i) * DM + 1024 + c0 + lane] = (bf16)f2bf(tile[lane * 65 + i] * gv);
            LDS_WAIT();
        }
        __syncthreads();
    }
}

__device__ __forceinline__ int trw_off(int row, int c8  , int GP) { return (row >> 2) * GP + (((c8 >> 1) * 4 + (row & 3)) * 32) + (c8 & 1) * 16; }
__device__ __forceinline__ void attn_phase(const bf16* proj, bf16* mixed, const float* rpb, const float* gain_a, LAS unsigned char* lds, int vb, int nb, int wave, int lane_in) {
    const int h = wave;
    LAS unsigned char* vt = lds + wave * 9216;
    LAS float* bt = (LAS float*)(lds + 73728 + wave * 1888);
    LAS float* ssx = (LAS float*)(lds + 73728 + 8 * 1888);
    for (int i = lane_in; i < 465; i += 64) bt[i] = rpb[h * 465 + i];
    LDS_WAIT();
    const bool wdeal = (nb == 256);
    const int u_first = wdeal ? (vb < 128 ? vb * 4 : 512 + (vb - 128) * 8) : vb, u_step = wdeal ? 1 : nb, u_end = wdeal ? u_first + (vb < 128 ? 4 : 8) : 1536;
    for (int unit = u_first; unit < u_end; unit += u_step) {
        int lane = lane_in; asm volatile("" : "+v"(lane));
        const int g = lane >> 4, qi = lane & 15;
        int r, cb, R, base;
        if (unit < 1024) { base = (unit >> 7) * 2048; r = (unit >> 2) & 31; cb = unit & 3; R = 32; } else { const int u2 = unit - 1024; base = 16384; r = u2 >> 2; cb = u2 & 3; R = 128; }
        const int row_start = min(max(r - 4, 0), R - 8), blk_start = min(max(16 * cb - 8, 0), 32);
        const int qtok = base + 64 * r + 16 * cb + qi;
        bf16x8 qf[4];
#pragma unroll
        for (int ks = 0; ks < 4; ++ks) qf[ks] = *(const bf16x8*)(proj + (size_t)qtok * NIN + C_AQ + h * 128 + ks * 32 + g * 8);
        f32x4 sc[16];
#pragma unroll
        for (int tq = 0; tq < 2; ++tq) {
            bf16x8 kf[8][4];
#pragma unroll
            for (int tt = 0; tt < 8; ++tt) { const int t = 8 * tq + tt;
                const int ktok = base + 64 * (row_start + (t >> 1)) + blk_start + 16 * (t & 1) + qi;
                const bf16* kp = proj + (size_t)ktok * NIN + C_AK + h * 128 + g * 8;
#pragma unroll
                for (int ks = 0; ks < 4; ++ks) kf[tt][ks] = *(const bf16x8*)(kp + ks * 32); }
#pragma unroll
            for (int tt = 0; tt < 8; ++tt) { f32x4 a = {0.f, 0.f, 0.f, 0.f};
#pragma unroll
                for (int ks = 0; ks < 4; ++ks) a = mfma16(kf[tt][ks], qf[ks], a);
                sc[8 * tq + tt] = a; }
        }
        const int qc = 16 * cb + qi, wst = min(max(qc - 8, 0), 48);
        float mx = -3.0e38f;
#pragma unroll
        for (int t = 0; t < 16; ++t) {
            const int dr = row_start + (t >> 1) - r + 7;
#pragma unroll
            for (int e = 0; e < 4; ++e) {
                const int kc = blk_start + 16 * (t & 1) + 4 * g + e, dc = min(max(kc - qc + 15, 0), 30);
                const bool valid = (kc >= wst) && (kc < wst + 16);
                const float v = valid ? sc[t][e] * 0.08838834764831845f + bt[dr * 31 + dc] : -1e30f;
                sc[t][e] = v; mx = fmaxf(mx, v);
            }
        }
        mx = fmaxf(mx, __shfl_xor(mx, 16)); mx = fmaxf(mx, __shfl_xor(mx, 32));
        float sum = 0.f;
#pragma unroll
        for (int t = 0; t < 16; ++t)
#pragma unroll
            for (int e = 0; e < 4; ++e) { const float p = __expf(sc[t][e] - mx); sc[t][e] = p; sum += p; }
        sum += __shfl_xor(sum, 16); sum += __shfl_xor(sum, 32);
        f32x4 o[8];
#pragma unroll
        for (int v = 0; v < 8; ++v) o[v] = (f32x4){0.f, 0.f, 0.f, 0.f};
        v4u vr[8];
        { const int vtok0 = base + 64 * row_start + blk_start;
#pragma unroll
          for (int i = 0; i < 8; ++i) { const int id = lane + 64 * i, j = id >> 4, ch = id & 15; vr[i] = *(const v4u*)(proj + (size_t)(vtok0 + j) * NIN + C_AV + h * 128 + ch * 8); } }
#pragma unroll
        for (int w = 0; w < 8; ++w) {
#pragma unroll
            for (int i = 0; i < 8; ++i) { const int id = lane + 64 * i, j = id >> 4, ch = id & 15; *(LAS v4u*)(vt + trw_off(j, ch, 1152)) = vr[i]; }
            if (w < 7) { const int vtok0 = base + 64 * (row_start + w + 1) + blk_start;
#pragma unroll
                for (int i = 0; i < 8; ++i) { const int id = lane + 64 * i, j = id >> 4, ch = id & 15; vr[i] = *(const v4u*)(proj + (size_t)(vtok0 + j) * NIN + C_AV + h * 128 + ch * 8); } }
            LDS_WAIT();
            bf16x8 pb;
            { v4u pw; pw.x = pk2(sc[2 * w][0], sc[2 * w][1]); pw.y = pk2(sc[2 * w][2], sc[2 * w][3]); pw.z = pk2(sc[2 * w + 1][0], sc[2 * w + 1][1]); pw.w = pk2(sc[2 * w + 1][2], sc[2 * w + 1][3]); pb = __builtin_bit_cast(bf16x8, pw); }
            const LAS unsigned char* tb = vt + g * 1152 + (qi >> 2) * 32 + (qi & 3) * 8;
#pragma unroll
            for (int v = 0; v < 8; ++v) {
                const s16x4 lo = tr16(tb + v * 128), hi = tr16(tb + 4 * 1152 + v * 128);
                o[v] = mfma16(cat8(lo, hi), pb, o[v]);
            }
            LDS_WAIT();
        }
        const float inv = 1.0f / sum;
        float ssq = 0.f;
#pragma unroll
        for (int v = 0; v < 8; ++v) { o[v] = o[v] * inv; ssq += (o[v].x * o[v].x + o[v].y * o[v].y) + (o[v].z * o[v].z + o[v].w * o[v].w); }
        ssq += __shfl_xor(ssq, 16); ssq += __shfl_xor(ssq, 32);
        if (g == 0) ssx[wave * 16 + qi] = ssq;
        __syncthreads();
        float tot = 0.f;
#pragma unroll
        for (int w = 0; w < 8; ++w) tot += ssx[w * 16 + qi];
        const float rs = 1.0f / sqrtf(tot * (1.0f / 1024.0f) + 1e-6f);
        __syncthreads();
#pragma unroll
        for (int v = 0; v < 8; ++v) {
            const int v0 = h * 128 + v * 16 + 4 * g;
            const f32x4 gn = *(const f32x4*)(gain_a + v0);
            v2u w; w.x = pk2(o[v].x * rs * gn.x, o[v].y * rs * gn.y); w.y = pk2(o[v].z * rs * gn.z, o[v].w * rs * gn.w);
            *(v2u*)(mixed + (size_t)qtok * DM + v0) = w;
        }
    }
}

__device__ __forceinline__ float ret_log_gamma(const float* dexp, int dir, int h) { return log1pf(-exp2f(-dexp[dir * 8 + h])); }
__device__ __forceinline__ void ret_scan(const bf16* proj, bf16* ST, bf16* FS, const float* dexp, LAS unsigned char* lds, int vb, int nb, int tid_in, int wave) {
    LAS unsigned char* Kt = lds;
    LAS unsigned char* Vt = lds + 34816;
    for (int c = vb; c < 384; c += nb) {
        int tid = tid_in; asm volatile("" : "+v"(tid));
        const int lane = tid & 63, g = lane >> 4, qi = lane & 15;
        const int vs = c >> 5, h = (c >> 2) & 7, dir = (c >> 1) & 1, dsl = c & 1;
        const bool seg = vs >= 8;
        const int base = seg ? 16384 + (vs - 8) * 2048 : vs * 2048, N = 16, nsteps = seg ? 16 : 15;
        const float lg = ret_log_gamma(dexp, dir, h), gC = expf(128.0f * lg);
        f32x4 acc[8][2];
#pragma unroll
        for (int m = 0; m < 8; ++m) { acc[m][0] = (f32x4){0.f, 0.f, 0.f, 0.f}; acc[m][1] = (f32x4){0.f, 0.f, 0.f, 0.f}; }
        v4u kr[4], vr[8];
        { const int n0 = dir == 0 ? 0 : N - 1, rowb = base + n0 * 128;
#pragma unroll
          for (int i = 0; i < 4; ++i) { const int id = tid + 512 * i, j = id >> 4, ch = id & 15; kr[i] = *(const v4u*)(proj + (size_t)(rowb + j) * NIN + C_RK + h * 256 + dsl * 128 + ch * 8); }
#pragma unroll
          for (int i = 0; i < 8; ++i) { const int id = tid + 512 * i, j = id >> 5, ch = id & 31; vr[i] = *(const v4u*)(proj + (size_t)(rowb + j) * NIN + C_RV + h * 256 + ch * 8); } }
        v2u stq[8][2]; bf16* dst_prev = nullptr;
        for (int step = 0; step <= nsteps; ++step) {
            const int n = dir == 0 ? step : N - 1 - step, tgt = dir == 0 ? n + 1 : n - 1;
            if (step < nsteps) {
                __syncthreads();
#pragma unroll
                for (int i = 0; i < 4; ++i) { const int id = tid + 512 * i, j = id >> 4, ch = id & 15;
                    v4u val = kr[i];
                    const float z = __expf(lg * (float)(dir == 0 ? 127 - j : j));
                    val.x = pk2(bflo(val.x) * z, bfhi(val.x) * z); val.y = pk2(bflo(val.y) * z, bfhi(val.y) * z); val.z = pk2(bflo(val.z) * z, bfhi(val.z) * z); val.w = pk2(bflo(val.w) * z, bfhi(val.w) * z);
                    *(LAS v4u*)(Kt + trw_off(j, ch, 1088)) = val; }
#pragma unroll
                for (int i = 0; i < 8; ++i) { const int id = tid + 512 * i, j = id >> 5, ch = id & 31; *(LAS v4u*)(Vt + trw_off(j, ch, 2112)) = vr[i]; }
                __syncthreads();
            }
            if (step > 0) {
#pragma unroll
                for (int m = 0; m < 8; ++m)
#pragma unroll
                    for (int nt = 0; nt < 2; ++nt) { const int v = (2 * wave + nt) * 16 + qi, d0 = dsl * 128 + m * 16 + 4 * g; *(v2u*)(dst_prev + v * 256 + d0) = stq[m][nt]; }
            }
            if (step == nsteps) break;
            if (step + 1 < nsteps) { const int n1 = dir == 0 ? step + 1 : N - 2 - step, rowb = base + n1 * 128;
#pragma unroll
                for (int i = 0; i < 4; ++i) { const int id = tid + 512 * i, j = id >> 4, ch = id & 15; kr[i] = *(const v4u*)(proj + (size_t)(rowb + j) * NIN + C_RK + h * 256 + dsl * 128 + ch * 8); }
#pragma unroll
                for (int i = 0; i < 8; ++i) { const int id = tid + 512 * i, j = id >> 5, ch = id & 31; vr[i] = *(const v4u*)(proj + (size_t)(rowb + j) * NIN + C_RV + h * 256 + ch * 8); } }
#pragma unroll
            for (int m = 0; m < 8; ++m) { acc[m][0] = acc[m][0] * gC; acc[m][1] = acc[m][1] * gC; }
#pragma unroll
            for (int ks = 0; ks < 4; ++ks) {
                const int rho = 8 * ks + 2 * g, lo8 = (qi >> 2) * 32 + (qi & 3) * 8;
                bf16x8 bfr[2];
#pragma unroll
                for (int nt = 0; nt < 2; ++nt) { const LAS unsigned char* p = Vt + rho * 2112 + (2 * wave + nt) * 128 + lo8; bfr[nt] = cat8(tr16(p), tr16(p + 2112)); }
#pragma unroll
                for (int m = 0; m < 8; ++m) { const LAS unsigned char* p = Kt + rho * 1088 + m * 128 + lo8; const bf16x8 af = cat8(tr16(p), tr16(p + 1088));
                    acc[m][0] = mfma16(af, bfr[0], acc[m][0]); acc[m][1] = mfma16(af, bfr[1], acc[m][1]); }
            }
            dst_prev = step < 15 ? ST + ((size_t)(((base >> 7) + tgt) * 8 + h) * 2 + dir) * 65536 : FS + ((size_t)((vs - 8) * 8 + h) * 2 + dir) * 65536;
#pragma unroll
            for (int m = 0; m < 8; ++m)
#pragma unroll
                for (int nt = 0; nt < 2; ++nt) { stq[m][nt].x = pk2(acc[m][nt].x, acc[m][nt].y); stq[m][nt].y = pk2(acc[m][nt].z, acc[m][nt].w); }
        }
        __syncthreads();
    }
}
__device__ __forceinline__ void ret_fix(bf16* ST, const bf16* FS, const float* dexp, int vb, int nb, int tid) {
    for (int it = vb; it < 64 * 8 * 2; it += nb) {
        const int dir = it & 1, h = (it >> 1) & 7, cl = it >> 4, sg = cl >> 4, nl = cl & 15;
        const int ncar = dir == 0 ? sg : 3 - sg;
        if (ncar == 0) continue;
        const bool loc = dir == 0 ? nl > 0 : nl < 15;
        const float lgd = ret_log_gamma(dexp, dir, h), c0 = __expf(lgd * 128.0f * (float)(dir == 0 ? nl : 15 - nl)), cs = __expf(lgd * 2048.0f);
        float cf[3]; cf[0] = c0; cf[1] = c0 * cs; cf[2] = c0 * cs * cs;
        bf16* dst = ST + ((size_t)((128 + cl) * 8 + h) * 2 + dir) * 65536;
#pragma unroll 4
        for (int i = 0; i < 16; ++i) { const int id = tid + 512 * i;
            v4u f[3];
#pragma unroll
            for (int k = 0; k < 3; ++k) if (k < ncar) { const int so = dir == 0 ? sg - 1 - k : sg + 1 + k; f[k] = ((const v4u*)(FS + ((size_t)(so * 8 + h) * 2 + dir) * 65536))[id]; }
            v4u l0 = {0u, 0u, 0u, 0u}; if (loc) l0 = ((const v4u*)dst)[id];
            float a[8] = {bflo(l0.x), bfhi(l0.x), bflo(l0.y), bfhi(l0.y), bflo(l0.z), bfhi(l0.z), bflo(l0.w), bfhi(l0.w)};
#pragma unroll
            for (int k = 0; k < 3; ++k) if (k < ncar) { const v4u q = f[k];
                a[0] += cf[k] * bflo(q.x); a[1] += cf[k] * bfhi(q.x); a[2] += cf[k] * bflo(q.y); a[3] += cf[k] * bfhi(q.y); a[4] += cf[k] * bflo(q.z); a[5] += cf[k] * bfhi(q.z); a[6] += cf[k] * bflo(q.w); a[7] += cf[k] * bfhi(q.w); }
            v4u r; r.x = pk2(a[0], a[1]); r.y = pk2(a[2], a[3]); r.z = pk2(a[4], a[5]); r.w = pk2(a[6], a[7]);
            ((v4u*)dst)[id] = r; }
    }
}
__device__ __forceinline__ void ret_out(const bf16* proj, const bf16* ST, bf16* mixed, const float* dexp, LAS unsigned char* lds, int vb, int nb, int tid_in0, int wave) {
    int tid_in = tid_in0; asm volatile("" : "+v"(tid_in));
    LAS unsigned char* Kt = lds;
    LAS unsigned char* Vt = lds + 67584;
    LAS unsigned char* Sx = lds;
    v4u pf[16];
    if (vb < 1536) { const int gc = vb >> 3, h = vb & 7, rowb = gc * 128;
#pragma unroll
        for (int i = 0; i < 8; ++i) { const int id = tid_in + 512 * i, j = id >> 5, ch = id & 31;
            pf[i] = *(const v4u*)(proj + (size_t)(rowb + j) * NIN + C_RK + h * 256 + ch * 8); pf[8 + i] = *(const v4u*)(proj + (size_t)(rowb + j) * NIN + C_RV + h * 256 + ch * 8); } }
    for (int unit = vb; unit < 1536; unit += nb) {
        int tid = tid_in; asm volatile("" : "+v"(tid));
        const int lane = tid & 63, g = lane >> 4, qi = lane & 15;
        const int gc = unit >> 3, h = unit & 7;
        const int n = gc < 128 ? (gc & 15) : gc - 128, N = gc < 128 ? 16 : 64;
        const int rowb = gc * 128, iq = 16 * wave + qi, qrow = rowb + iq;
        const bool have_f = n > 0, have_b = n < N - 1;
        const float lgf = ret_log_gamma(dexp, 0, h), lgb = ret_log_gamma(dexp, 1, h);
        __syncthreads();
#pragma unroll
        for (int i = 0; i < 8; ++i) { const int id = tid + 512 * i, j = id >> 5, ch = id & 31;
            *(LAS v4u*)(Kt + j * 528 + ch * 16) = pf[i]; *(LAS v4u*)(Vt + trw_off(j, ch, 2176)) = pf[8 + i]; }
        bf16x8 qf[8];
#pragma unroll
        for (int ks = 0; ks < 8; ++ks) qf[ks] = *(const bf16x8*)(proj + (size_t)qrow * NIN + C_RQ + h * 256 + ks * 32 + g * 8);
        __syncthreads();
        if (have_f) { const bf16* src = ST + ((size_t)(gc * 8 + h) * 2 + 0) * 65536;
#pragma unroll
            for (int i = 0; i < 16; ++i) { const int id = tid + 512 * i; pf[i] = *(const v4u*)(src + (id >> 5) * 256 + (id & 31) * 8); } }
        f32x4 o[16];
#pragma unroll
        for (int v = 0; v < 16; ++v) o[v] = (f32x4){0.f, 0.f, 0.f, 0.f};
#pragma unroll
        for (int k2 = 0; k2 < 4; ++k2) {
            f32x4 st[2];
#pragma unroll
            for (int jj = 0; jj < 2; ++jj) {
                const int jt = 2 * k2 + jj;
                f32x4 a = {0.f, 0.f, 0.f, 0.f};
                const LAS unsigned char* kp = Kt + (jt * 16 + qi) * 528 + g * 16;
#pragma unroll
                for (int ks = 0; ks < 8; ++ks) a = mfma16(*(const LAS bf16x8*)(kp + ks * 64), qf[ks], a);
#pragma unroll
                for (int e = 0; e < 4; ++e) { const int df = iq - (jt * 16 + 4 * g + e); a[e] *= df >= 0 ? __expf(lgf * (float)df) : __expf(lgb * (float)(-df)); }
                st[jj] = a;
            }
            bf16x8 pb;
            { v4u pw; pw.x = pk2(st[0][0], st[0][1]); pw.y = pk2(st[0][2], st[0][3]); pw.z = pk2(st[1][0], st[1][1]); pw.w = pk2(st[1][2], st[1][3]); pb = __builtin_bit_cast(bf16x8, pw); }
            const LAS unsigned char* tb = Vt + (8 * k2 + g) * 2176 + (qi >> 2) * 32 + (qi & 3) * 8;
#pragma unroll
            for (int v = 0; v < 16; ++v) { o[v] = mfma16(cat8(tr16(tb + v * 128), tr16(tb + 4 * 2176 + v * 128)), pb, o[v]); if ((v & 3) == 3) asm volatile("" ::: "memory"); }
        }
#pragma unroll
        for (int dir = 0; dir < 2; ++dir) {
            const bool have = dir == 0 ? have_f : have_b;
            __syncthreads();
            if (have) {
#pragma unroll
                for (int i = 0; i < 16; ++i) { const int id = tid + 512 * i; *(LAS v4u*)(Sx + (id >> 5) * 528 + (id & 31) * 16) = pf[i]; } }
            __syncthreads();
            if (dir == 0) { if (have_b) { const bf16* src = ST + ((size_t)(gc * 8 + h) * 2 + 1) * 65536;
#pragma unroll
                    for (int i = 0; i < 16; ++i) { const int id = tid + 512 * i; pf[i] = *(const v4u*)(src + (id >> 5) * 256 + (id & 31) * 8); } } }
            else { const int un = unit + nb;
                if (un < 1536) { const int gc2 = un >> 3, h2 = un & 7, rowb2 = gc2 * 128;
#pragma unroll
                    for (int i = 0; i < 8; ++i) { const int id = tid + 512 * i, j = id >> 5, ch = id & 31;
                        pf[i] = *(const v4u*)(proj + (size_t)(rowb2 + j) * NIN + C_RK + h2 * 256 + ch * 8); pf[8 + i] = *(const v4u*)(proj + (size_t)(rowb2 + j) * NIN + C_RV + h2 * 256 + ch * 8); } } }
            if (have) {
                const float xi = dir == 0 ? __expf(lgf * (float)(iq + 1)) : __expf(lgb * (float)(128 - iq));
#pragma unroll
                for (int kh = 0; kh < 2; ++kh) {
                    bf16x8 qs[4];
#pragma unroll
                    for (int k4 = 0; k4 < 4; ++k4) { const int ks = 4 * kh + k4; const v4u q = *(const v4u*)(proj + (size_t)qrow * NIN + C_RQ + h * 256 + ks * 32 + g * 8); v4u r;
                        r.x = pk2(bflo(q.x) * xi, bfhi(q.x) * xi); r.y = pk2(bflo(q.y) * xi, bfhi(q.y) * xi); r.z = pk2(bflo(q.z) * xi, bfhi(q.z) * xi); r.w = pk2(bflo(q.w) * xi, bfhi(q.w) * xi);
                        qs[k4] = __builtin_bit_cast(bf16x8, r); }
#pragma unroll
                    for (int v = 0; v < 16; ++v) {
                        const LAS unsigned char* sp = Sx + (v * 16 + qi) * 528 + g * 16 + kh * 256;
#pragma unroll
                        for (int k4 = 0; k4 < 4; ++k4) o[v] = mfma16(*(const LAS bf16x8*)(sp + k4 * 64), qs[k4], o[v]);
                        if ((v & 1) == 1) asm volatile("" ::: "memory");
                    }
                }
            }
        }
        float ssq = 0.f;
#pragma unroll
        for (int v = 0; v < 16; ++v) ssq += (o[v].x * o[v].x + o[v].y * o[v].y) + (o[v].z * o[v].z + o[v].w * o[v].w);
        ssq += __shfl_xor(ssq, 16); ssq += __shfl_xor(ssq, 32);
        const float rs = 1.0f / sqrtf(ssq * (1.0f / 256.0f) + 1e-6f);
#pragma unroll
        for (int v = 0; v < 16; ++v) {
            const int v0 = h * 256 + v * 16 + 4 * g;
            const v2u gw = *(const v2u*)(proj + (size_t)qrow * NIN + C_RG + v0);
            const float g0 = bflo(gw.x), g1 = bfhi(gw.x), g2 = bflo(gw.y), g3 = bfhi(gw.y);
            v2u w; w.x = pk2(o[v].x * rs * g0 / (1.0f + __expf(-g0)), o[v].y * rs * g1 / (1.0f + __expf(-g1)));
            w.y = pk2(o[v].z * rs * g2 / (1.0f + __expf(-g2)), o[v].w * rs * g3 / (1.0f + __expf(-g3)));
            *(v2u*)(mixed + (size_t)qrow * DM + 2048 + v0) = w;
            if ((v & 3) == 3) asm volatile("" ::: "memory");
        }
    }
    __syncthreads();
}

#define FFT_HD __device__ __attribute__((always_inline))
#define FFT_BREV __brev
#ifdef FFT_HOST_TEST
struct cf2 { float x, y; };
#else
typedef float cf2 __attribute__((ext_vector_type(2)));
#endif
FFT_HD inline cf2 cmulf(cf2 a, cf2 b) { cf2 r; r.x = a.x * b.x - a.y * b.y; r.y = a.x * b.y + a.y * b.x; return r; }
FFT_HD inline cf2 cmulcf(cf2 a, cf2 b) { cf2 r; r.x = a.x * b.x + a.y * b.y; r.y = a.y * b.x - a.x * b.y; return r; }
FFT_HD inline int fpad(int i) { return i + (i >> 3); }
FFT_HD inline constexpr float fc32(int k) {
    return k == 0 ? 1.0f : k == 1 ? 0.98078528040323043f : k == 2 ? 0.92387953251128674f : k == 3 ? 0.83146961230254524f : k == 4 ? 0.70710678118654752f :
           k == 5 ? 0.55557023301960218f : k == 6 ? 0.38268343236508978f : k == 7 ? 0.19509032201612825f : k == 8 ? 0.0f :
           k == 9 ? -0.19509032201612825f : k == 10 ? -0.38268343236508978f : k == 11 ? -0.55557023301960218f : k == 12 ? -0.70710678118654752f :
           k == 13 ? -0.83146961230254524f : k == 14 ? -0.92387953251128674f : k == 15 ? -0.98078528040323043f : -1.0f;
}
FFT_HD inline constexpr float fs32(int k) { return k <= 8 ? fc32(8 - k) : fc32(k - 8); }
FFT_HD inline constexpr int fbrev(int j, int bits) { int r = 0; for (int b = 0; b < bits; ++b) r |= ((j >> b) & 1) << (bits - 1 - b); return r; }

template <int R> FFT_HD inline void dft_fwd_reg(cf2 (&v)[1 << R]) {
    constexpr int n = 1 << R;
#pragma unroll
    for (int s = 0; s < R; ++s) {
        const int half = n >> (s + 1);
#pragma unroll
        for (int m = 0; m < n; ++m) {
            if ((m & half) == 0) {
                const int ml = m & (half - 1), tk = ml * (16 / half);
                const cf2 a = v[m], b = v[m + half];
                v[m].x = a.x + b.x; v[m].y = a.y + b.y;
                const cf2 d = {a.x - b.x, a.y - b.y};
                if (tk == 0) v[m + half] = d;
                else if (tk == 8) { v[m + half].x = d.y; v[m + half].y = -d.x; }
                else { const cf2 w = {fc32(tk), -fs32(tk)}; v[m + half] = cmulf(d, w); }
            }
        }
    }
}
template <int R> FFT_HD inline void dft_inv_reg(cf2 (&v)[1 << R]) {
    constexpr int n = 1 << R;
#pragma unroll
    for (int s = R - 1; s >= 0; --s) {
        const int half = n >> (s + 1);
#pragma unroll
        for (int m = 0; m < n; ++m) {
            if ((m & half) == 0) {
                const int ml = m & (half - 1), tk = ml * (16 / half);
                const cf2 a = v[m], bb = v[m + half]; cf2 b;
                if (tk == 0) b = bb;
                else if (tk == 8) { b.x = -bb.y; b.y = bb.x; }
                else { const cf2 w = {fc32(tk), -fs32(tk)}; b = cmulcf(bb, w); }
                v[m].x = a.x + b.x; v[m].y = a.y + b.y; v[m + half].x = a.x - b.x; v[m + half].y = a.y - b.y;
            }
        }
    }
}
template <int R, int F, bool CONJ> FFT_HD inline void tw_apply(cf2 (&v)[1 << R], cf2 pf, cf2 th) {
    constexpr int j = fbrev(F, R);
    v[j] = CONJ ? cmulcf(v[j], pf) : cmulf(v[j], pf);
    if constexpr (2 * F < (1 << R)) {
        const cf2 p2 = cmulf(pf, pf);
        tw_apply<R, 2 * F, CONJ>(v, p2, th);
        const cf2 p3 = cmulf(p2, th);
        tw_apply<R, 2 * F + 1, CONJ>(v, p3, th);
    }
}
template <int R, int S> FFT_HD inline int grp_base(int grp) { return (grp / S) * (S << R) + (grp & (S - 1)); }
template <int R, int S, class P> FFT_HD inline void grp_load(P X, int grp, cf2 (&v)[1 << R]) {
    P Xb = X + fpad(grp_base<R, S>(grp));
#pragma unroll
    for (int m = 0; m < (1 << R); ++m) v[m] = Xb[m * S + ((m * S) >> 3)];
}
template <int R, int S, class P> FFT_HD inline void grp_store(P X, int grp, const cf2 (&v)[1 << R]) {
    P Xb = X + fpad(grp_base<R, S>(grp));
#pragma unroll
    for (int m = 0; m < (1 << R); ++m) Xb[m * S + ((m * S) >> 3)] = v[m];
}
template <int R> FFT_HD inline void reg_fwd(cf2 (&v)[1 << R], cf2 th) { dft_fwd_reg<R>(v); tw_apply<R, 1, false>(v, th, th); }
template <int R> FFT_HD inline void reg_inv(cf2 (&v)[1 << R], cf2 th) { tw_apply<R, 1, true>(v, th, th); dft_inv_reg<R>(v); }
template <int R, class P> FFT_HD inline void lds_ld(P X, int grp, int logS, cf2 (&v)[1 << R]) {
    const int base = ((grp >> logS) << (logS + R)) + (grp & ((1 << logS) - 1));
    P Xb = X + fpad(base);
#pragma unroll
    for (int m = 0; m < (1 << R); ++m) { const int o = m << logS; v[m] = Xb[o + (o >> 3)]; }
}
template <int R, class P> FFT_HD inline void lds_st(P X, int grp, int logS, const cf2 (&v)[1 << R]) {
    const int base = ((grp >> logS) << (logS + R)) + (grp & ((1 << logS) - 1));
    P Xb = X + fpad(base);
#pragma unroll
    for (int m = 0; m < (1 << R); ++m) { const int o = m << logS; Xb[o + (o >> 3)] = v[m]; }
}
template <class LP> FFT_HD inline void p_step(int step, int t, int fi, LP X, LP Kb0t, LP Kb1t, const cf2* TW, float* hv, const float* hx1, const float* hx2, const float* f0, const float* f1) {
    if (step == 3) {
        const float s = 0.5f / 4096.0f;
#pragma unroll 4
        for (int m = 0; m < 16; ++m) { const int p = 16 * t + m, f = (int)(FFT_BREV((unsigned)p) >> 20), p2 = (int)(FFT_BREV((unsigned)((4096 - f) & 4095)) >> 20);
            const cf2 z = X[fpad(p)], w = X[fpad(p2)]; cf2 k;
            if (fi == 0) { k.x = s * (z.x + w.x); k.y = s * (z.y - w.y); Kb0t[256 * m] = k; } else { k.x = s * (z.y + w.y); k.y = s * (w.x - z.x); Kb1t[256 * m] = k; } }
        return;
    }
    int pos, r = 0;
    bool filt = step < 3;
    if (filt) pos = step; else { r = (step - 4) / 9; pos = (step - 4) - 9 * r; }
    const int pp = pos >= 5 && pos <= 7 ? pos - 4 : pos;
    const int pr = 2 * r + fi;
    const int logS = (pp == 0 || pp == 4 || pp == 8) ? 8 : (pp == 2 ? 0 : 4);
    const bool do_inv = (pp == 3 || pp == 4 || pp == 8), do_fwd = (pp == 0 || pp == 1 || pp == 2 || pp == 4), do_k = (pp == 2 && !filt);
    const cf2 th = (logS == 8) ? TW[t * 4] : TW[(t & 15) * 64];
    cf2 v[16];
    if (pp == 0) {
        if (filt) {
#pragma unroll
            for (int m = 0; m < 16; ++m) { v[m].x = f0[t + 256 * m]; v[m].y = f1[t + 256 * m]; }
        } else { const float* a = hv + pr * 4096 + t;
#pragma unroll
            for (int m = 0; m < 16; ++m) { v[m].x = m < 8 ? a[256 * m] : 0.f; v[m].y = m < 8 ? a[2048 + 256 * m] : 0.f; } }
    } else lds_ld<4>(X, t, logS, v);
    float ga[8], gb[8];
    if (pp == 4 || pp == 8) { const float* g = (pos == 4 ? hx1 : hx2) + pr * 4096 + t;
#pragma unroll
        for (int m = 0; m < 8; ++m) { ga[m] = g[256 * m]; gb[m] = g[2048 + 256 * m]; } }
    if (do_inv) { if (logS != 0) tw_apply<4, 1, true>(v, th, th); dft_inv_reg<4>(v); }
    if (pp == 4) {
#pragma unroll
        for (int m = 0; m < 16; ++m) { v[m].x = m < 8 ? v[m].x * ga[m] : 0.f; v[m].y = m < 8 ? v[m].y * gb[m] : 0.f; } }
    if (pp == 8) { float* a = hv + pr * 4096 + t;
#pragma unroll
        for (int m = 0; m < 8; ++m) { a[256 * m] = v[m].x * ga[m]; a[2048 + 256 * m] = v[m].y * gb[m]; }
        return; }
    if (do_fwd) { dft_fwd_reg<4>(v); if (logS != 0) tw_apply<4, 1, false>(v, th, th); }
    if (do_k) { LP K = (pos == 2) ? Kb0t : Kb1t;
#pragma unroll
        for (int m = 0; m < 16; ++m) v[m] = cmulf(v[m], K[256 * m]);
        dft_inv_reg<4>(v); }
    lds_st<4>(X, t, logS, v);
}
template <class LP> FFT_HD inline void s_step(int step, int t, LP X, const cf2* TW, const float* hv, const float* hx1, const float* hx2, const float* f0, const float* f1, float* outp) {
    const int s7 = step >= 7 ? step - 6 : step;
    if (s7 == 3) {
        const float sc = 0.25f / 16384.0f;
#pragma unroll 4
        for (int j = 0; j < 32; ++j) {
            const int p = t + 512 * j, f = (int)(FFT_BREV((unsigned)p) >> 18), f2 = (16384 - f) & 16383;
            if (f <= f2) { const int p2 = (int)(FFT_BREV((unsigned)f2) >> 18);
                const cf2 z = X[fpad(p)], w = X[fpad(p2)];
                const float P = z.x * z.x - z.y * z.y - w.x * w.x + w.y * w.y, Q = 2.0f * (z.x * z.y + w.x * w.y);
                cf2 a, b; a.x = Q * sc; a.y = -P * sc; b.x = Q * sc; b.y = P * sc;
                X[fpad(p)] = a; X[fpad(p2)] = b; }
        }
        return;
    }
    if (s7 == 2 || s7 == 4) {
#pragma unroll 1
        for (int q = 0; q < 2; ++q) { const int grp = t + 512 * q; cf2 v[16]; lds_ld<4>(X, grp, 0, v); if (s7 == 2) dft_fwd_reg<4>(v); else dft_inv_reg<4>(v); lds_st<4>(X, grp, 0, v); }
        return;
    }
    const bool isA = (step == 0 || step == 6 || step == 12);
    const int logS = isA ? 9 : 4;
    const bool do_inv = (step == 5 || step == 6 || step == 11 || step == 12), do_fwd = (step == 0 || step == 1 || step == 6 || step == 7);
    const cf2 th = isA ? TW[t] : TW[(t & 15) * 32];
    cf2 v[32];
    if (step == 0) {
#pragma unroll
        for (int m = 0; m < 32; ++m) { v[m].x = m < 16 ? hv[t + 512 * m] : 0.f; v[m].y = f0[t + 512 * m]; }
    } else lds_ld<5>(X, t, logS, v);
    if (do_inv) { tw_apply<5, 1, true>(v, th, th); dft_inv_reg<5>(v); }
    if (step == 6) {
#pragma unroll
        for (int m = 0; m < 32; ++m) { v[m].x = m < 16 ? v[m].x * hx1[t + 512 * m] : 0.f; v[m].y = f1[t + 512 * m]; } }
    if (step == 12) {
#pragma unroll
        for (int m = 0; m < 16; ++m) outp[t + 512 * m] = v[m].x * hx2[t + 512 * m];
        return; }
    if (do_fwd) { dft_fwd_reg<5>(v);
#if defined(DBG_FFT_EXTRA)
        dft_inv_reg<5>(v);
#pragma unroll
        for (int m = 0; m < 32; ++m) { v[m].x *= 0.03125f; v[m].y *= 0.03125f; }
        dft_fwd_reg<5>(v);
#endif
        tw_apply<5, 1, false>(v, th, th); }
    lds_st<5>(X, t, logS, v);
}
typedef LAS cf2* ldsc;
#define HC_NO_P 1
#ifndef HC_UNITS
#define HC_UNITS 1024
#endif
__device__ __forceinline__ cf2 tw_fresh(cf2 th) { asm volatile("" : "+v"(th.x), "+v"(th.y)); return th; }
__device__ __forceinline__ void s_mid2(ldsc X, const cf2* TW, int tid) {
#pragma unroll 1
    for (int q = 0; q < 2; ++q) { const int grp = tid + 512 * q; cf2 v[16]; grp_load<4, 64>(X, grp, v); reg_fwd<4>(v, TW[(grp & 63) * 16]); grp_store<4, 64>(X, grp, v); }
    __syncthreads();
#pragma unroll 1
    for (int q = 0; q < 4; ++q) { const int grp = tid + 512 * q; cf2 v[8]; grp_load<3, 8>(X, grp, v); reg_fwd<3>(v, TW[(grp & 7) * 256]); grp_store<3, 8>(X, grp, v); }
    __syncthreads();
#pragma unroll 1
    for (int q = 0; q < 4; ++q) { const int grp = tid + 512 * q; cf2 v[8]; grp_load<3, 1>(X, grp, v); dft_fwd_reg<3>(v); grp_store<3, 1>(X, grp, v); }
    __syncthreads();
    { const float sc = 0.25f / 16384.0f;
#pragma unroll 4
      for (int j = 0; j < 32; ++j) {
        const int p = tid + 512 * j, f = (int)(__brev((unsigned)p) >> 18), f2 = (16384 - f) & 16383;
        if (f <= f2) { const int p2 = (int)(__brev((unsigned)f2) >> 18);
            const cf2 z = X[fpad(p)], w = X[fpad(p2)];
            const float P = z.x * z.x - z.y * z.y - w.x * w.x + w.y * w.y, Q = 2.0f * (z.x * z.y + w.x * w.y);
            cf2 a, b; a.x = Q * sc; a.y = -P * sc; b.x = Q * sc; b.y = P * sc;
            X[fpad(p)] = a; X[fpad(p2)] = b; }
      } }
    __syncthreads();
#pragma unroll 1
    for (int q = 0; q < 4; ++q) { const int grp = tid + 512 * q; cf2 v[8]; grp_load<3, 1>(X, grp, v); dft_inv_reg<3>(v); grp_store<3, 1>(X, grp, v); }
    __syncthreads();
#pragma unroll 1
    for (int q = 0; q < 4; ++q) { const int grp = tid + 512 * q; cf2 v[8]; grp_load<3, 8>(X, grp, v); reg_inv<3>(v, TW[(grp & 7) * 256]); grp_store<3, 8>(X, grp, v); }
    __syncthreads();
#pragma unroll 1
    for (int q = 0; q < 2; ++q) { const int grp = tid + 512 * q; cf2 v[16]; grp_load<4, 64>(X, grp, v); reg_inv<4>(v, TW[(grp & 63) * 16]); grp_store<4, 64>(X, grp, v); }
    __syncthreads();
}
__device__ __forceinline__ void hyena_conv_s2(const float* HYT, float* ZOUT, const float* FILT, const cf2* TW, LAS unsigned char* lds, int vb, int nb, int tid_in) {
    ldsc X = (ldsc)lds;
    for (int u = vb; u < 1024; u += nb) {
        int tid = tid_in; asm volatile("" : "+v"(tid));
        __syncthreads();
        const int c = u;
        const float* hv = HYT + (size_t)c * MTOK + 16384; const float* hx1 = HYT + (size_t)(1024 + c) * MTOK + 16384; const float* hx2 = HYT + (size_t)(2048 + c) * MTOK + 16384;
        float* zo = ZOUT + (size_t)c * MTOK + 16384;
        const float* f0 = FILT + FILT_L1_OFF + (size_t)c * 16384; const float* f1 = FILT + FILT_L1_OFF + (size_t)(1024 + c) * 16384;
#pragma unroll 1
        for (int q = 0; q < 2; ++q) { const int grp = tid + 512 * q; cf2 v[16];
#pragma unroll
            for (int m = 0; m < 16; ++m) { v[m].x = m < 8 ? hv[grp + 1024 * m] : 0.f; v[m].y = f0[grp + 1024 * m]; }
            reg_fwd<4>(v, TW[grp]); grp_store<4, 1024>(X, grp, v); }
        __syncthreads();
        s_mid2(X, TW, tid);
#pragma unroll 1
        for (int q = 0; q < 2; ++q) { const int grp = tid + 512 * q; cf2 v[16]; float g1[8], fl[16];
#pragma unroll
            for (int m = 0; m < 16; ++m) { if (m < 8) g1[m] = hx1[grp + 1024 * m]; fl[m] = f1[grp + 1024 * m]; }
            const cf2 th = TW[grp];
            grp_load<4, 1024>(X, grp, v); reg_inv<4>(v, th);
#pragma unroll
            for (int m = 0; m < 16; ++m) { v[m].x = m < 8 ? v[m].x * g1[m] : 0.f; v[m].y = fl[m]; }
            reg_fwd<4>(v, tw_fresh(th)); grp_store<4, 1024>(X, grp, v); }
        __syncthreads();
        s_mid2(X, TW, tid);
#pragma unroll 1
        for (int q = 0; q < 2; ++q) { const int grp = tid + 512 * q; cf2 v[16]; float g2[8];
#pragma unroll
            for (int m = 0; m < 8; ++m) g2[m] = hx2[grp + 1024 * m];
            grp_load<4, 1024>(X, grp, v); reg_inv<4>(v, TW[grp]);
#pragma unroll
            for (int m = 0; m < 8; ++m) zo[grp + 1024 * m] = v[m].x * g2[m]; }
    }
    __syncthreads();
}
__device__ __forceinline__ void hyena_conv(const float* HYT, float* ZOUT, const float* FILT, const cf2* TW, LAS unsigned char* lds, int vb, int nb, int tid_in) {
    for (int u = vb; u < HC_UNITS; u += nb) {
        int tid = tid_in; asm volatile("" : "+v"(tid));
        __syncthreads();
#ifndef HC_NO_S
        if (u < 1024) {
            const int c = u;
            const float* hv = HYT + (size_t)c * MTOK + 16384; float* zo = ZOUT + (size_t)c * MTOK + 16384; const float* hx1 = HYT + (size_t)(1024 + c) * MTOK + 16384; const float* hx2 = HYT + (size_t)(2048 + c) * MTOK + 16384;
            const float* f0 = FILT + FILT_L1_OFF + (size_t)c * 16384; const float* f1 = FILT + FILT_L1_OFF + (size_t)(1024 + c) * 16384;
#pragma unroll 1
            for (int step = 0; step < 13; ++step) { int st = step, tt = tid; asm volatile("" : "+s"(st), "+v"(tt)); s_step(st, tt, (ldsc)lds, TW, hv, hx1, hx2, f0, f1, zo); __syncthreads(); }
        }
#endif
#ifndef HC_NO_P
        if (u >= 1024) {
            const int c = u - 1024, fi = tid >> 8, t = tid & 255;
            float* hv = HYT + (size_t)c * MTOK; const float* hx1 = HYT + (size_t)(1024 + c) * MTOK; const float* hx2 = HYT + (size_t)(2048 + c) * MTOK;
            const float* f0 = FILT + (size_t)c * 4096; const float* f1 = FILT + (size_t)(1024 + c) * 4096;
            ldsc X = (ldsc)(lds + fi * 36864);
#pragma unroll 1
            for (int step = 0; step < 22; ++step) { int st = step, tt = t; asm volatile("" : "+s"(st), "+v"(tt)); p_step(st, tt, fi, X, (ldsc)(lds + 73728) + tt, (ldsc)(lds + 73728 + 32768) + tt, TW, hv, hx1, hx2, f0, f1); __syncthreads(); }
        }
#endif
    }
    __syncthreads();
}

#define FFT_LDSU LAS unsigned
#define FFT_SINCOSPI sincospif
typedef _Float16 hf16;
typedef hf16 h8v __attribute__((ext_vector_type(8)));
typedef hf16 h2v __attribute__((ext_vector_type(2)));
struct cplx { float x, y; };
constexpr int FM_PITCH = 272;
constexpr int FM_BUF = 64 * FM_PITCH;
FFT_HD inline unsigned fm_pack(float re, float im) { h2v h; h.x = (hf16)re; h.y = (hf16)im; return __builtin_bit_cast(unsigned, h); }
FFT_HD inline float fm_fblk(int w, int ks, int lane, int j) {
    const int x = lane & 15, g = lane >> 4, k1 = 8 * w + (x >> 1), part = x & 1, r = 16 * ks + 4 * g + (j >> 1), pp = j & 1;
    float sn, cs; FFT_SINCOSPI(2.0f * (float)((k1 * r) & 63) / 64.0f, &sn, &cs);
    return part == 0 ? (pp == 0 ? cs : sn) : (pp == 0 ? -sn : cs);
}
FFT_HD inline cplx fm_tw(int w, int lane, int nt, int q) {
    const int k1 = 8 * w + 2 * (lane >> 4) + q, c = 16 * nt + (lane & 15);
    float sn, cs; FFT_SINCOSPI(-2.0f * (float)((k1 * c) & 4095) / 4096.0f, &sn, &cs); cplx t; t.x = cs; t.y = sn; return t;
}
FFT_HD inline int fm_boff(int lane, int nt, int ks) { return (16 * nt + (lane & 15)) * FM_PITCH + (16 * ks + 4 * (lane >> 4)) * 4; }
template <class BP> FFT_HD inline void fm_e1(BP dst, int w, int lane, int nt, const float (&a)[4], const cplx (&tw)[2]) {
    const int g = lane >> 4, c = 16 * nt + (lane & 15);
#pragma unroll
    for (int q = 0; q < 2; ++q) { const float yr = a[2 * q], yi = a[2 * q + 1]; const int k1 = 8 * w + 2 * g + q;
        *(FFT_LDSU*)(dst + k1 * FM_PITCH + c * 4) = fm_pack(yr * tw[q].x - yi * tw[q].y, yr * tw[q].y + yi * tw[q].x); }
}
template <class BP> FFT_HD inline void fm_e2(BP dst, int w, int lane, int nt, const float (&a)[4], const cplx (&K)[2]) {
    const int g = lane >> 4, k1 = 16 * nt + (lane & 15), k2 = 8 * w + 2 * g;
    unsigned o[2];
#pragma unroll
    for (int q = 0; q < 2; ++q) { const float xr = a[2 * q], xi = a[2 * q + 1]; o[q] = fm_pack(xr * K[q].x - xi * K[q].y, -(xr * K[q].y + xi * K[q].x)); }
    FFT_LDSU* p = (FFT_LDSU*)(dst + k1 * FM_PITCH + k2 * 4); p[0] = o[0]; p[1] = o[1];
}
template <class BP> FFT_HD inline void fm_e3(BP dst, int w, int lane, int nt, const float (&a)[4], const float* ga, const float* gb) {
    const int g = lane >> 4, k1 = 16 * nt + (lane & 15), k2 = 8 * w + 2 * g;
    unsigned o[2] = {0u, 0u};
    if (w < 4) {
#pragma unroll
        for (int q = 0; q < 2; ++q) { const int t = k1 + 64 * (k2 + q); o[q] = fm_pack(a[2 * q] * ga[t], -a[2 * q + 1] * gb[t]); } }
    FFT_LDSU* p = (FFT_LDSU*)(dst + k1 * FM_PITCH + k2 * 4); p[0] = o[0]; p[1] = o[1];
}
FFT_HD inline void fm_e4(float* oa, float* ob, int w, int lane, int nt, const float (&a)[4], const float* ga, const float* gb) {
    if (w < 4) { const int g = lane >> 4, k1 = 16 * nt + (lane & 15), k2 = 8 * w + 2 * g;
#pragma unroll
        for (int q = 0; q < 2; ++q) { const int t = k1 + 64 * (k2 + q); oa[t] = a[2 * q] * ga[t]; ob[t] = -a[2 * q + 1] * gb[t]; } }
}
template <class FP> FFT_HD inline void fm_e2f(FP nmf, int w, int lane, int nt, const float (&a)[4]) {
    const int g = lane >> 4, k1 = 16 * nt + (lane & 15), k2 = 8 * w + 2 * g;
#pragma unroll
    for (int q = 0; q < 2; ++q) { const int f = k1 + 64 * (k2 + q); nmf[2 * f] = a[2 * q]; nmf[2 * f + 1] = a[2 * q + 1]; }
}
template <class FP> FFT_HD inline void fm_split(FP nmf, int w, int lane, int nt, cplx (&K0)[2], cplx (&K1)[2]) {
    const int g = lane >> 4, k1 = 16 * nt + (lane & 15), k2 = 8 * w + 2 * g; const float s = 0.5f / 4096.0f;
#pragma unroll
    for (int q = 0; q < 2; ++q) { const int f = k1 + 64 * (k2 + q), f2 = (4096 - f) & 4095;
        const float zr = nmf[2 * f], zi = nmf[2 * f + 1], wr = nmf[2 * f2], wi = nmf[2 * f2 + 1];
        K0[q].x = s * (zr + wr); K0[q].y = s * (zi - wi); K1[q].x = s * (zi + wi); K1[q].y = s * (wr - zr); }
}
template <class BP> FFT_HD inline void fm_load(BP dst, int tid, const float* a, const float* b, bool full) {
#pragma unroll
    for (int i = 0; i < 4; ++i) { const int t = tid + 512 * i;
        *(FFT_LDSU*)(dst + (t & 63) * FM_PITCH + (t >> 6) * 4) = fm_pack(a[t], b[t]);
        const int t2 = t + 2048;
        *(FFT_LDSU*)(dst + (t2 & 63) * FM_PITCH + (t2 >> 6) * 4) = full ? fm_pack(a[t2], b[t2]) : 0u; }
}
template <class BP> FFT_HD inline void fm_e3v(BP dst, int w, int lane, int nt, const float (&a)[4], const float (&ga)[2], const float (&gb)[2]) {
    const int g = lane >> 4, k1 = 16 * nt + (lane & 15), k2 = 8 * w + 2 * g;
    unsigned o[2] = {0u, 0u};
    if (w < 4) { o[0] = fm_pack(a[0] * ga[0], -a[1] * gb[0]); o[1] = fm_pack(a[2] * ga[1], -a[3] * gb[1]); }
    FFT_LDSU* p = (FFT_LDSU*)(dst + k1 * FM_PITCH + k2 * 4); p[0] = o[0]; p[1] = o[1];
}
FFT_HD inline unsigned fm_tidx(int w, int lane, int nt, int q) { return (unsigned)(16 * nt + (lane & 15) + 64 * (8 * w + 2 * (lane >> 4) + q)); }
typedef LAS unsigned char* ldsb;
struct FmConst { h8v afr[4]; cplx tw[4][2]; };
__device__ __forceinline__ void fm_matmul(ldsb buf, int lane, const FmConst& C, f32x4 (&acc)[4]) {
#pragma unroll
    for (int nt = 0; nt < 4; ++nt) acc[nt] = (f32x4){0.f, 0.f, 0.f, 0.f};
#pragma unroll
    for (int ks = 0; ks < 4; ++ks)
#pragma unroll
        for (int nt = 0; nt < 4; ++nt) acc[nt] = __builtin_amdgcn_mfma_f32_16x16x32_f16(C.afr[ks], *(const LAS h8v*)(buf + fm_boff(lane, nt, ks)), acc[nt], 0, 0, 0);
}
__device__ __forceinline__ void fm_sweep(ldsb lds, int& cur, int w, int lane, const FmConst& C, f32x4 (&acc)[4]) {
    fm_matmul(lds + cur * FM_BUF, lane, C, acc);
#pragma unroll
    for (int nt = 0; nt < 4; ++nt) { const float a[4] = {acc[nt].x, acc[nt].y, acc[nt].z, acc[nt].w}; fm_e1(lds + (cur ^ 1) * FM_BUF, w, lane, nt, a, C.tw[nt]); }
    __syncthreads(); cur ^= 1;
    fm_matmul(lds + cur * FM_BUF, lane, C, acc);
}
__device__ __forceinline__ void hyena_conv_p(const float* HYT, float* ZOUT, const float* FILT, const unsigned char* fmtab, LAS unsigned char* lds, int vb, int nb, int tid_in) {
    FmConst C;
    { int tid = tid_in; asm volatile("" : "+v"(tid));
#pragma unroll
      for (int ks = 0; ks < 4; ++ks) C.afr[ks] = ((const h8v*)fmtab)[tid * 4 + ks];
#pragma unroll
      for (int nt = 0; nt < 4; ++nt) { C.tw[nt][0] = ((const cplx*)(fmtab + 32768))[tid * 8 + 2 * nt]; C.tw[nt][1] = ((const cplx*)(fmtab + 32768))[tid * 8 + 2 * nt + 1]; } }
    LAS float* nmf = (LAS float*)(lds + 2 * FM_BUF);
    for (int u = vb; u < 1024; u += nb) {
        int tid = tid_in; asm volatile("" : "+v"(tid));
        const int lane = tid & 63, w = __builtin_amdgcn_readfirstlane(tid >> 6);
        const int c = u;
        const float* hv = HYT + (size_t)c * MTOK; float* zo = ZOUT + (size_t)c * MTOK; const float* hx1 = HYT + (size_t)(1024 + c) * MTOK; const float* hx2 = HYT + (size_t)(2048 + c) * MTOK;
        const float* f0 = FILT + (size_t)c * 4096; const float* f1 = FILT + (size_t)(1024 + c) * 4096;
        int cur = 0; f32x4 acc[4];
        cplx K0[4][2], K1[4][2];
        __syncthreads();
        fm_load(lds, tid, f0, f1, true);
        __syncthreads();
        fm_sweep(lds, cur, w, lane, C, acc);
#pragma unroll
        for (int nt = 0; nt < 4; ++nt) { const float a[4] = {acc[nt].x, acc[nt].y, acc[nt].z, acc[nt].w}; fm_e2f(nmf, w, lane, nt, a); }
        __syncthreads(); cur ^= 1;
#pragma unroll
        for (int nt = 0; nt < 4; ++nt) fm_split(nmf, w, lane, nt, K0[nt], K1[nt]);
#pragma unroll 1
        for (int pr = 0; pr < 4; ++pr) {
            const float* va = hv + pr * 4096; const float* x1a = hx1 + pr * 4096; const float* x2a = hx2 + pr * 4096; float* oa = zo + pr * 4096;
            __syncthreads();
            fm_load(lds + cur * FM_BUF, tid, va, va + 2048, false);
            float ga[4][2], gb[4][2];
            if (w < 4) {
#pragma unroll
                for (int nt = 0; nt < 4; ++nt)
#pragma unroll
                    for (int q = 0; q < 2; ++q) { const unsigned t = fm_tidx(w, lane, nt, q); ga[nt][q] = x1a[t]; gb[nt][q] = x1a[2048u + t]; } }
            __syncthreads();
            fm_sweep(lds, cur, w, lane, C, acc);
#pragma unroll
            for (int nt = 0; nt < 4; ++nt) { const float a[4] = {acc[nt].x, acc[nt].y, acc[nt].z, acc[nt].w}; fm_e2(lds + (cur ^ 1) * FM_BUF, w, lane, nt, a, K0[nt]); }
            __syncthreads(); cur ^= 1;
            fm_sweep(lds, cur, w, lane, C, acc);
#pragma unroll
            for (int nt = 0; nt < 4; ++nt) { const float a[4] = {acc[nt].x, acc[nt].y, acc[nt].z, acc[nt].w}; fm_e3v(lds + (cur ^ 1) * FM_BUF, w, lane, nt, a, ga[nt], gb[nt]); }
            if (w < 4) {
#pragma unroll
                for (int nt = 0; nt < 4; ++nt)
#pragma unroll
                    for (int q = 0; q < 2; ++q) { const unsigned t = fm_tidx(w, lane, nt, q); ga[nt][q] = x2a[t]; gb[nt][q] = x2a[2048u + t]; } }
            __syncthreads(); cur ^= 1;
            fm_sweep(lds, cur, w, lane, C, acc);
#pragma unroll
            for (int nt = 0; nt < 4; ++nt) { const float a[4] = {acc[nt].x, acc[nt].y, acc[nt].z, acc[nt].w}; fm_e2(lds + (cur ^ 1) * FM_BUF, w, lane, nt, a, K1[nt]); }
            __syncthreads(); cur ^= 1;
            fm_sweep(lds, cur, w, lane, C, acc);
            if (w < 4) {
#pragma unroll
                for (int nt = 0; nt < 4; ++nt)
#pragma unroll
                    for (int q = 0; q < 2; ++q) { const unsigned t = fm_tidx(w, lane, nt, q); const float yr = q ? acc[nt].z : acc[nt].x, yi = q ? acc[nt].w : acc[nt].y; oa[t] = yr * ga[nt][q]; oa[2048u + t] = -yi * gb[nt][q]; } }
            cur ^= 1;
        }
    }
    __syncthreads();
}

__device__ __forceinline__ void fm_tables(unsigned char* fmtab, int tid) {
    const int lane = tid & 63, w = tid >> 6;
#pragma unroll
    for (int ks = 0; ks < 4; ++ks) { h8v a;
#pragma unroll
        for (int j = 0; j < 8; ++j) a[j] = (hf16)fm_fblk(w, ks, lane, j);
        ((h8v*)fmtab)[tid * 4 + ks] = a; }
#pragma unroll
    for (int nt = 0; nt < 4; ++nt) { ((cplx*)(fmtab + 32768))[tid * 8 + 2 * nt] = fm_tw(w, lane, nt, 0); ((cplx*)(fmtab + 32768))[tid * 8 + 2 * nt + 1] = fm_tw(w, lane, nt, 1); }
}

#ifndef PMASK
#define PMASK 0xFFFF
#endif
#define PM(b) ((PMASK >> (b)) & 1)
#ifndef DBG_DOUBLE
#define DBG_DOUBLE 0
#endif
struct Args { const float* in[26]; float* out; unsigned char* ws; int ph_lo, ph_hi, li, pad; };
typedef const __attribute__((address_space(4))) unsigned char* kaptr;
__device__ __forceinline__ kaptr ka_fresh() { kaptr p = (kaptr)__builtin_amdgcn_kernarg_segment_ptr(); asm volatile("" : "+s"(p)); return p; }
#define KA_IN(ka, i) (*(const float* const __attribute__((address_space(4)))*)((ka) + 8 * (i)))
#define KA_OUT(ka) (*(float* const __attribute__((address_space(4)))*)((ka) + 208))
#define KA_WS(ka) (*(unsigned char* const __attribute__((address_space(4)))*)((ka) + 216))
#define KA_INT(ka, off) (*(const int __attribute__((address_space(4)))*)((ka) + (off)))
__global__ void __launch_bounds__(NT, 2) fwd_kernel(Args args_unused) {
    extern __shared__ __attribute__((aligned(16))) unsigned char lds_raw[];
    LAS unsigned char* lds = (LAS unsigned char*)lds_raw;
    volatile LAS unsigned* MISC = (volatile LAS unsigned*)(lds + MISC_OFF);
    const int tid0 = threadIdx.x;
#define PHASE_IDS() int vcu = vcu0, G = G0; asm volatile("" : "+s"(vcu), "+s"(G)); const int ngw = G * NWAVES; (void)ngw; int tid = tid0; asm volatile("" : "+v"(tid)); const int lane = tid & 63, wave = __builtin_amdgcn_readfirstlane(tid >> 6), gw = vcu * NWAVES + wave; (void)lane; (void)gw
    const int G0 = gridDim.x, bx = blockIdx.x, vcu0 = (G0 % 8 == 0) ? (bx % 8) * (G0 / 8) + bx / 8 : bx;
    for (int u = tid0; u < (LDS_BYTES - MISC_OFF) / 4; u += NT) ((LAS unsigned*)(lds + MISC_OFF))[u] = 0u;
    __syncthreads();
    int lo, hi;
    XcdBarrier bar;
    { kaptr ka = ka_fresh(); lo = KA_INT(ka, 224); hi = KA_INT(ka, 228); unsigned* ctl = (unsigned*)(KA_WS(ka) + WS_CTL) + CW_BAR + KA_INT(ka, 232) * XCD_BAR_WORDS;
      bar.bar = ctl; bar.x = 0; bar.st = MISC + 8;
      if (hi - lo > 1) bar = xcd_barrier_post(ctl, MISC + 8); }
#define IN(k) (lo <= (k) && (k) < hi)
#define SEAM(k) do { if (IN(k) && IN((k) + 1)) { XcdBarrier b2 = bar; asm volatile("" : "+s"(b2.x)); xcd_barrier(b2); } } while (0)
#define WSP(T, off) ((T*)(ws + (off)))

    if (IN(0)) {
        PHASE_IDS(); kaptr ka = ka_fresh(); unsigned char* ws = KA_WS(ka); float* xres = KA_OUT(ka);
        if (PM(0)) for (int m = gw; m < MTOK; m += ngw) { const float* src = m < 16384 ? KA_IN(ka, 0) + (size_t)m * DM : KA_IN(ka, 1) + (size_t)(m - 16384) * DM;
            ln_row_in(src, KA_IN(ka, 2), KA_IN(ka, 3), WSP(bf16, WS_XB) + (size_t)m * DM, WSP(signed char, WS_XQ) + (size_t)m * DM, WSP(float, WS_ROWINV3) + m, lane); }
        for (int l2 = 0; l2 < 2; ++l2) { const float* wl = KA_IN(ka, 4) + (size_t)l2 * DM * NIN; unsigned* cm = WSP(unsigned, WS_CTL) + CW_CMAX + l2 * NIN;
            colmax_f32(wl, DM, NIN, 4096, cm, gw, ngw, lane); colmax_f32(wl + C_RQ, DM, NIN, 8192, cm + C_RQ, gw, ngw, lane); }
        if (vcu == 0) fm_tables(WSP(unsigned char, WS_FMTAB), tid);
        if (PM(1)) pre_tables(KA_IN(ka, 8), KA_IN(ka, 9), KA_IN(ka, 10), KA_IN(ka, 11), KA_IN(ka, 12), ws, gw, ngw, lane);
        { unsigned* ctl = WSP(unsigned, WS_CTL); const size_t n4 = (size_t)DM * NFF2 / 4;
          absmax_f32(KA_IN(ka, 22), n4, ctl + CW_WMAX, (size_t)gw * 64 + lane, (size_t)ngw * 64, lane);
          absmax_f32(KA_IN(ka, 22) + (size_t)DM * NFF2, n4, ctl + CW_WMAX + 1, (size_t)gw * 64 + lane, (size_t)ngw * 64, lane);
          const size_t m4 = (size_t)DFF * DM / 4;
          absmax_f32(KA_IN(ka, 23), m4, ctl + CW_WMAX + 2, (size_t)gw * 64 + lane, (size_t)ngw * 64, lane);
          absmax_f32(KA_IN(ka, 23) + (size_t)DFF * DM, m4, ctl + CW_WMAX + 3, (size_t)gw * 64 + lane, (size_t)ngw * 64, lane); }
    }
    SEAM(0);
    if (IN(1)) {
        PHASE_IDS(); kaptr ka = ka_fresh(); unsigned char* ws = KA_WS(ka);
        for (int rep = 0; rep < 1 + ((DBG_DOUBLE >> 2) & 1); ++rep) if (PM(2)) convert_weights(KA_IN(ka, 4), KA_IN(ka, 19), KA_IN(ka, 22), KA_IN(ka, 23), ws, WSP(const unsigned, WS_CTL) + CW_WMAX, WSP(const unsigned, WS_CTL) + CW_CMAX, lds, gw, ngw, wave, lane);
    }
    SEAM(1);
    for (int l = 0; l < 2; ++l) {
        const int P = 2 + l * NPH;
        if (IN(P + 0)) {
            PHASE_IDS(); kaptr ka = ka_fresh(); unsigned char* ws = KA_WS(ka);
            { pg8::Gemm g{WSP(bf16, WS_XB), WSP(const bf16, WS_WIN), MTOK, NB16, DM}; pg8::StaticOrder S; S.init(MTOK, NB16, G, bx);
              pg8::EpiProj E{WSP(bf16, WS_PROJ), WSP(const float, WS_ROPE)};
              if (PM(3)) pg8::gemm_phase<pg8::EpiProj, pg8::StaticOrder, true, true, false, true>(lds, g, S, E); }
            { pg8::Gemm g{WSP(bf16, WS_XQ), WSP(const bf16, WS_WINQ), MTOK, NQN, DM}; pg8::StaticOrder S; S.init(MTOK, NQN, G, bx);
              pg8::EpiProjV E{WSP(bf16, WS_PROJ), WSP(const float, WS_ROPE), WSP(const float, WS_ROWINV3), WSP(const float, WS_CTL) + CW_CMAX + l * NIN};
              if (PM(3)) pg8::gemm_phase<pg8::EpiProjV, pg8::StaticOrder, true, true, true>(lds, g, S, E); }
        }
        SEAM(P + 0);
        for (int mrep = 0; mrep < 1 + ((DBG_DOUBLE >> 1) & 1); ++mrep) {
        if (IN(P + 1)) for (int rp1 = 0; rp1 < 1 + ((DBG_DOUBLE >> 10) & 1); ++rp1) {
            PHASE_IDS(); kaptr ka = ka_fresh(); unsigned char* ws = KA_WS(ka); __syncthreads();
#if !defined(DBG_NO_RET)
            for (int rq = 0; rq < 1 + ((DBG_DOUBLE >> 13) & 1); ++rq) { __syncthreads(); if (PM(4)) ret_scan(WSP(const bf16, WS_PROJ), WSP(bf16, WS_ST), WSP(bf16, WS_FS), KA_IN(ka, 16) + l * 16, lds, vcu, G, tid, wave); }
            if (DBG_DOUBLE & (3 << 13)) { XcdBarrier b3 = bar; asm volatile("" : "+s"(b3.x)); xcd_barrier(b3); }
#endif
#if !defined(DBG_NO_ATT)
            for (int rq = 0; rq < 1 + ((DBG_DOUBLE >> 14) & 1); ++rq) { __syncthreads(); if (PM(5)) attn_phase(WSP(const bf16, WS_PROJ), WSP(bf16, WS_MIXED), KA_IN(ka, 5) + l * 3720, KA_IN(ka, 17) + l * 1024, lds, vcu, G, wave, lane); }
            if (DBG_DOUBLE & 16) { __syncthreads(); attn_phase(WSP(const bf16, WS_PROJ), WSP(bf16, WS_MIXED), KA_IN(ka, 5) + l * 3720, KA_IN(ka, 17) + l * 1024, lds, vcu, G, wave, lane); }
#endif
            __syncthreads();
#if !defined(DBG_NO_HY)
            if (PM(6)) hyena_transpose(WSP(const bf16, WS_PROJ), KA_IN(ka, 6) + l * 9216, KA_IN(ka, 7) + l * 3072, WSP(float, WS_HYT), lds, gw, ngw, wave, lane);
            if (DBG_DOUBLE & 32) { __syncthreads(); hyena_transpose(WSP(const bf16, WS_PROJ), KA_IN(ka, 6) + l * 9216, KA_IN(ka, 7) + l * 3072, WSP(float, WS_HYT), lds, gw, ngw, wave, lane); }
            if (PM(7)) filter_assembly(KA_IN(ka, 13) + (size_t)l * 64 * 4096, KA_IN(ka, 14) + l * 4096, KA_IN(ka, 15) + l * 2048, WSP(const float, WS_H2) + (size_t)l * 10240 * 64, WSP(float, WS_FILT), lds, vcu, G, tid, wave, lane);
            if (DBG_DOUBLE & 32) { __syncthreads(); filter_assembly(KA_IN(ka, 13) + (size_t)l * 64 * 4096, KA_IN(ka, 14) + l * 4096, KA_IN(ka, 15) + l * 2048, WSP(const float, WS_H2) + (size_t)l * 10240 * 64, WSP(float, WS_FILT), lds, vcu, G, tid, wave, lane); }
#endif
        }
        SEAM(P + 1);
        if (IN(P + 2)) for (int rp2 = 0; rp2 < 1 + ((DBG_DOUBLE >> 11) & 1); ++rp2) {
            PHASE_IDS(); kaptr ka = ka_fresh(); unsigned char* ws = KA_WS(ka); __syncthreads();
#if !defined(DBG_NO_HY)
            if (PM(8)) { hyena_conv_s2(WSP(const float, WS_HYT), WSP(float, WS_ZOUT), WSP(const float, WS_FILT), WSP(const cf2, WS_TW), lds, vcu, G, tid); hyena_conv_p(WSP(const float, WS_HYT), WSP(float, WS_ZOUT), WSP(const float, WS_FILT), WSP(const unsigned char, WS_FMTAB), lds, vcu, G, tid); }
            if (DBG_DOUBLE & 256) hyena_conv(WSP(const float, WS_HYT), WSP(float, WS_ZOUT), WSP(const float, WS_FILT), WSP(const cf2, WS_TW), lds, vcu, G, tid);
            if (DBG_DOUBLE & 512) hyena_conv_p(WSP(const float, WS_HYT), WSP(float, WS_ZOUT), WSP(const float, WS_FILT), WSP(const unsigned char, WS_FMTAB), lds, vcu, G, tid);
#endif
#if !defined(DBG_NO_RET)
            if (PM(9)) ret_fix(WSP(bf16, WS_ST), WSP(const bf16, WS_FS), KA_IN(ka, 16) + l * 16, vcu, G, tid);
#endif
        }
        SEAM(P + 2);
        if (IN(P + 3)) for (int rp3 = 0; rp3 < 1 + ((DBG_DOUBLE >> 12) & 1); ++rp3) {
            PHASE_IDS(); kaptr ka = ka_fresh(); unsigned char* ws = KA_WS(ka); __syncthreads();
#if !defined(DBG_NO_RET)
            if (PM(9)) ret_out(WSP(const bf16, WS_PROJ), WSP(const bf16, WS_ST), WSP(bf16, WS_MIXED), KA_IN(ka, 16) + l * 16, lds, vcu, G, tid, wave);
#endif
#if !defined(DBG_NO_HY)
            if (PM(10)) hyena_norm(WSP(const float, WS_ZOUT), KA_IN(ka, 18) + l * 1024, WSP(bf16, WS_MIXED), lds, vcu, G, wave, lane);
            if (DBG_DOUBLE & 128) { __syncthreads(); hyena_norm(WSP(const float, WS_ZOUT), KA_IN(ka, 18) + l * 1024, WSP(bf16, WS_MIXED), lds, vcu, G, wave, lane); }
#endif
#if defined(DBG_NO_ATT) || defined(DBG_NO_HY) || defined(DBG_NO_RET)
            for (size_t i = (size_t)(bx * NT + tid); i < (size_t)MTOK * DM / 8; i += (size_t)G * NT) { const int col = (int)((i * 8) % DM); bool z = false;
#if defined(DBG_NO_ATT)
                z |= col < 1024;
#endif
#if defined(DBG_NO_HY)
                z |= (col >= 1024 && col < 2048);
#endif
#if defined(DBG_NO_RET)
                z |= col >= 2048;
#endif
                if (z) WSP(v4u, WS_MIXED)[i] = (v4u){0u, 0u, 0u, 0u}; }
#endif
        }
        SEAM(P + 3);
        }
        if (IN(P + 4)) {
            PHASE_IDS(); kaptr ka = ka_fresh(); unsigned char* ws = KA_WS(ka);
            pg8::Gemm g{WSP(bf16, WS_MIXED), WSP(const bf16, WS_WOUT), MTOK, DM, DM}; pg8::StaticOrder S; S.init(MTOK, DM, G, bx);
            pg8::EpiRes E{WSP(pg8::bf16_t, WS_XR), WSP(const pg8::bf16_t, WS_XB), ALPHA};
            if (PM(11)) pg8::gemm_phase<pg8::EpiRes, pg8::StaticOrder, true, true>(lds, g, S, E);
        }
        SEAM(P + 4);
        if (IN(P + 5)) {
            PHASE_IDS(); kaptr ka = ka_fresh(); unsigned char* ws = KA_WS(ka);
            for (int m0 = gw; m0 < MTOK; m0 += ngw) { const int m = row_perm(m0); ln_row_qb(WSP(const bf16, WS_XR) + (size_t)m * DM, KA_IN(ka, 20) + l * DM, KA_IN(ka, 21) + l * DM, WSP(signed char, WS_XB) + (size_t)m * DM, WSP(float, WS_ROWINV) + m, WSP(float, WS_STATS) + 2 * m, lane); }
        }
        SEAM(P + 5);
        if (IN(P + 6)) {
            PHASE_IDS(); kaptr ka = ka_fresh(); unsigned char* ws = KA_WS(ka);
            pg8::Gemm g{WSP(bf16, WS_XB), WSP(const bf16, WS_WFI), MTOK, NFF2, DM}; pg8::StaticOrder S; S.init(MTOK, NFF2, G, bx);
            pg8::EpiSwigluQ E{WSP(bf16, WS_PROJ), WSP(const float, WS_ROWINV), WSP(const unsigned, WS_CTL) + CW_WMAX + l};
            if (PM(12)) pg8::gemm_phase<pg8::EpiSwigluQ, pg8::StaticOrder, true, true, true>(lds, g, S, E);
        }
        SEAM(P + 6);
        if (IN(P + 7)) {
            PHASE_IDS(); kaptr ka = ka_fresh(); unsigned char* ws = KA_WS(ka);
            for (int m0 = gw; m0 < MTOK; m0 += ngw) { const int m = row_perm(m0); quant_row_h(WSP(const bf16, WS_PROJ) + (size_t)m * DFF, WSP(signed char, WS_HQ) + (size_t)m * DFF, WSP(float, WS_ROWINV2) + m, lane); }
        }
        SEAM(P + 7);
        if (IN(P + 8)) {
            PHASE_IDS(); kaptr ka = ka_fresh(); unsigned char* ws = KA_WS(ka);
            pg8::Gemm g{WSP(bf16, WS_HQ), WSP(const bf16, WS_WFO), MTOK, DM, DFF}; pg8::StaticOrder S; S.init(MTOK, DM, G, bx);
            pg8::EpiResQ E{WSP(pg8::bf16_t, WS_XR), ALPHA, WSP(const float, WS_ROWINV2), WSP(const unsigned, WS_CTL) + CW_WMAX + 2 + l, WSP(const float, WS_STATS), KA_IN(ka, 20) + l * DM, KA_IN(ka, 21) + l * DM};
            if (PM(13)) pg8::gemm_phase<pg8::EpiResQ, pg8::StaticOrder, true, true, true>(lds, g, S, E);
        }
        SEAM(P + 8);
        if (IN(P + 9)) {
            PHASE_IDS(); kaptr ka = ka_fresh(); unsigned char* ws = KA_WS(ka); float* xres = KA_OUT(ka);
            if (l == 0) { for (int m0 = gw; m0 < MTOK; m0 += ngw) { const int m = row_perm(m0); ln_row_b_in(WSP(const bf16, WS_XR) + (size_t)m * DM, KA_IN(ka, 24), KA_IN(ka, 25), WSP(bf16, WS_XB) + (size_t)m * DM, WSP(signed char, WS_XQ) + (size_t)m * DM, WSP(float, WS_ROWINV3) + m, lane); } }
            else { for (int m0 = gw; m0 < MTOK; m0 += ngw) { const int m = row_perm(m0); ln_row_b<true>(WSP(const bf16, WS_XR) + (size_t)m * DM, KA_IN(ka, 24) + DM, KA_IN(ka, 25) + DM, xres + (size_t)m * DM, (bf16*)nullptr, lane); } }
            if (l == 0 && PM(2)) convert_weights(KA_IN(ka, 4) + (size_t)DM * NIN, KA_IN(ka, 19) + (size_t)DM * DM, KA_IN(ka, 22) + (size_t)DM * NFF2, KA_IN(ka, 23) + (size_t)DFF * DM, ws, WSP(const unsigned, WS_CTL) + CW_WMAX + 1, WSP(const unsigned, WS_CTL) + CW_CMAX + NIN, lds, gw, ngw, wave, lane);
        }
        SEAM(P + 9);
    }
#undef IN
#undef SEAM
}

extern "C" void kernel_launch(void* const* d_in, const int* in_sizes, int n_in, void* d_out, int out_size, void* d_ws, size_t ws_size, hipStream_t stream) {
    static int grid = 0;
    if (grid == 0) {
        if (n_in != 26 || out_size != MTOK * DM || ws_size < WS_END) { fprintf(stderr, "kernel_launch: unexpected problem (n_in %d, out %d, ws %zu < %zu)\n", n_in, out_size, ws_size, (size_t)WS_END); grid = -1; return; }
        int dev = 0, cus = 0, per_cu = 0;
        if (hipGetDevice(&dev) != hipSuccess || hipDeviceGetAttribute(&cus, hipDeviceAttributeMultiprocessorCount, dev) != hipSuccess) { grid = -1; return; }
        if (hipFuncSetAttribute((const void*)fwd_kernel, hipFuncAttributeMaxDynamicSharedMemorySize, LDS_BYTES) != hipSuccess) { fprintf(stderr, "kernel_launch: hipFuncSetAttribute failed\n"); grid = -1; return; }
        if (hipOccupancyMaxActiveBlocksPerMultiprocessor(&per_cu, (const void*)fwd_kernel, NT, LDS_BYTES) != hipSuccess || per_cu < 1) fprintf(stderr, "kernel_launch: occupancy query says %d\n", per_cu);
        (void)hipGetLastError();
        grid = cus;
    }
    if (grid < 0) return;
    if (hipMemsetAsync((char*)d_ws + WS_CTL, 0, CTL_ZERO_BYTES, stream) != hipSuccess) return;
    Args a{};
    for (int i = 0; i < 26; ++i) a.in[i] = (const float*)d_in[i];
    a.out = (float*)d_out; a.ws = (unsigned char*)d_ws; a.pad = 0;
#if MK_N_LAUNCHES == 1
    a.ph_lo = 0; a.ph_hi = N_PHASES; a.li = 0;
    hipLaunchKernelGGL(fwd_kernel, dim3(grid), dim3(NT), LDS_BYTES, stream, a);
#else
    for (int p = 0; p < N_PHASES; ++p) { a.ph_lo = p; a.ph_hi = p + 1; a.li = 0; hipLaunchKernelGGL(fwd_kernel, dim3(grid), dim3(NT), LDS_BYTES, stream, a); }
#endif
}
```
